# Optimizing an MI355X kernel written in HIP

```python
import math
import jax, jax.numpy as jnp
from jax import lax
import numpy as np

D_MODEL = 4096
BATCH = 1
SEQ = 8192
DEPTH = 1

POOL_GROUPS = 4
POOL_GROUP_WIDTH = 512
POOL_WIDTH = POOL_GROUPS * POOL_GROUP_WIDTH
POOL_WINDOWS = (2, 4, 8, 16)
N_HEADS = 16
N_KV_GROUPS = 4
HEADS_PER_GROUP = N_HEADS // N_KV_GROUPS
HEAD_DIM = 128
Q_WIDTH = N_HEADS * HEAD_DIM
KV_WIDTH = N_KV_GROUPS * HEAD_DIM
CMP_BLOCK = 32
CMP_STRIDE = 16
SLC_BLOCK = 64
SLC_TOPK = 16
WINDOW = 512
Q_BLOCK = 128
FORCE_SCORE = 1e4
PEER_HEADS = 8
PEER_NKEYS = 128
PEER_N_EXPERTS = PEER_NKEYS * PEER_NKEYS
PEER_QDIM = 256
PEER_HALF = PEER_QDIM // 2
PEER_TOPK = 16
PEER_TOKEN_BLOCK = 128
PLE_DIM = 256
RMS_EPS = 1e-6
NEG = -1e30
IN_SPLITS = (POOL_WIDTH, Q_WIDTH, 6 * KV_WIDTH, 3 * N_HEADS, D_MODEL, D_MODEL)
IN_WIDTH = sum(IN_SPLITS)

kernel_name = "hybrid_pool_nsa_peer_block"


def rms_norm(x, g):
    xf = x.astype(jnp.float32)
    y = xf * lax.rsqrt(jnp.mean(xf * xf, axis=-1, keepdims=True) + RMS_EPS)
    return (y * g.astype(jnp.float32)).astype(x.dtype)


def alibi_slopes():
    s = 2.0 ** (-8.0 * np.arange(1, N_HEADS + 1) / N_HEADS)
    return jnp.asarray(s, dtype=jnp.float32).reshape(N_KV_GROUPS, HEADS_PER_GROUP)


def pool_mixer(u, pool_w, pool_scale):
    B, T, _ = u.shape
    ug = u.astype(jnp.float32).reshape(B, T, POOL_GROUPS, POOL_GROUP_WIDTH)
    cs = jnp.cumsum(ug, axis=1)
    pos = jnp.arange(T, dtype=jnp.float32)
    outs = []
    for gi, w in enumerate(POOL_WINDOWS):
        c = cs[:, :, gi]
        lower = jnp.pad(c, ((0, 0), (w, 0), (0, 0)))[:, :T]
        cnt = jnp.minimum(pos + 1.0, float(w))[None, :, None]
        outs.append((c - lower) / cnt)
    pooled = jnp.stack(outs, axis=2) - ug
    mixed = jnp.einsum('btgc,gcd->btgd', pooled.astype(u.dtype), pool_w)
    return mixed.reshape(B, T, POOL_WIDTH) * pool_scale


def compress_blocks(kv, pos_emb, w):
    T = kv.shape[1]
    n_cmp = (T - CMP_BLOCK) // CMP_STRIDE + 1
    idx = (np.arange(n_cmp)[:, None] * CMP_STRIDE + np.arange(CMP_BLOCK)[None, :]).astype(np.int32)
    blocks = kv[:, idx] + pos_emb[None, None, :, None, :]
    return jnp.einsum('bnlgd,ldc->bngc', blocks, w.reshape(CMP_BLOCK, HEAD_DIM, HEAD_DIM))


def nsa_attention(q, k_cmp, v_cmp, k_slc, v_slc, k_win, v_win, gates,
                  cmp_pos_k, cmp_pos_v, cmp_w_k, cmp_w_v):
    B, T = q.shape[:2]
    G, Hg, dk = N_KV_GROUPS, HEADS_PER_GROUP, HEAD_DIM
    slopes = alibi_slopes()
    qh = (q.reshape(B, T, G, Hg, dk) * (dk ** -0.5)).transpose(0, 2, 3, 1, 4)
    tpos = jnp.arange(T, dtype=jnp.int32)

    kc = compress_blocks(k_cmp, cmp_pos_k, cmp_w_k)
    vc = compress_blocks(v_cmp, cmp_pos_v, cmp_w_v)
    n_cmp = kc.shape[1]
    cmp_end = jnp.arange(n_cmp, dtype=jnp.int32) * CMP_STRIDE + CMP_BLOCK - 1
    dist_c = (tpos[:, None] - cmp_end[None, :]).astype(jnp.float32)
    valid_c = dist_c >= 0
    s_c = jnp.einsum('bghtd,bngd->bghtn', qh, kc).astype(jnp.float32) \
        - slopes[None, :, :, None, None] * dist_c
    s_c = jnp.where(valid_c, s_c, NEG)
    p_c = jax.nn.softmax(s_c, axis=-1) * valid_c
    o_cmp = jnp.einsum('bghtn,bngd->bghtd', p_c.astype(vc.dtype), vc)

    n_sel = T // SLC_BLOCK
    k_sel = min(SLC_TOPK, n_sel)
    c_start = np.arange(n_cmp) * CMP_STRIDE
    s_start = np.arange(n_sel) * SLC_BLOCK
    overlap = ((c_start[:, None] < s_start[None, :] + SLC_BLOCK) &
               (c_start[:, None] + CMP_BLOCK > s_start[None, :])).astype(np.float32)
    imp = jnp.einsum('bghtn,nk->bgtk', p_c, jnp.asarray(overlap))
    cur = (tpos // SLC_BLOCK)[:, None]
    kk = jnp.arange(n_sel, dtype=jnp.int32)[None, :]
    forced = (kk == 0) | (kk == cur) | (kk == cur - 1)
    score = jnp.where(forced, FORCE_SCORE, jnp.where(kk <= cur, imp, -1.0))
    _, sel_idx = lax.top_k(score, k_sel)
    sel_ok = sel_idx <= cur[None, None]

    n_qb = T // Q_BLOCK
    ks = k_slc.reshape(B, n_sel, SLC_BLOCK, G, dk).transpose(0, 3, 1, 2, 4)
    vs = v_slc.reshape(B, n_sel, SLC_BLOCK, G, dk).transpose(0, 3, 1, 2, 4)
    q_b = jnp.moveaxis(qh.reshape(B, G, Hg, n_qb, Q_BLOCK, dk), 3, 0)
    idx_b = jnp.moveaxis(sel_idx.reshape(B, G, n_qb, Q_BLOCK, k_sel), 2, 0)
    ok_b = jnp.moveaxis(sel_ok.reshape(B, G, n_qb, Q_BLOCK, k_sel), 2, 0)
    t_b = tpos.reshape(n_qb, Q_BLOCK)
    bi = jnp.arange(B)[:, None, None, None]
    gi = jnp.arange(G)[None, :, None, None]
    in_blk = jnp.arange(SLC_BLOCK, dtype=jnp.int32)

    def sel_block(args):
        qb, ib, okb, tb = args
        kg = ks[bi, gi, ib]
        vg = vs[bi, gi, ib]
        spos = ib[..., None] * SLC_BLOCK + in_blk
        d = tb[None, None, :, None, None] - spos
        m = okb[..., None] & (d >= 0)
        sc = jnp.einsum('bghqd,bgqkld->bghqkl', qb, kg).astype(jnp.float32) \
            - slopes[None, :, :, None, None, None] * d[:, :, None].astype(jnp.float32)
        sc = jnp.where(m[:, :, None], sc, NEG)
        sh = sc.shape
        pr = jax.nn.softmax(sc.reshape(sh[:4] + (-1,)), axis=-1).reshape(sh)
        return jnp.einsum('bghqkl,bgqkld->bghqd', pr.astype(vg.dtype), vg)

    o_slc = lax.map(sel_block, (q_b, idx_b, ok_b, t_b))
    o_slc = jnp.moveaxis(o_slc, 0, 3).reshape(B, G, Hg, T, dk)

    span = WINDOW + Q_BLOCK
    kp = jnp.pad(k_win, ((0, 0), (WINDOW, 0), (0, 0), (0, 0)))
    vp = jnp.pad(v_win, ((0, 0), (WINDOW, 0), (0, 0), (0, 0)))
    widx = (np.arange(n_qb)[:, None] * Q_BLOCK + np.arange(span)[None, :]).astype(np.int32)
    kw = kp[:, widx]
    vw = vp[:, widx]
    spos_w = jnp.asarray(widx - WINDOW)
    d_w = t_b[:, :, None] - spos_w[:, None, :]
    m_w = (d_w >= 0) & (d_w < WINDOW) & (spos_w[:, None, :] >= 0)
    qw = qh.reshape(B, G, Hg, n_qb, Q_BLOCK, dk)
    s_w = jnp.einsum('bghiqd,bisgd->bghiqs', qw, kw).astype(jnp.float32) \
        - slopes[None, :, :, None, None, None] * d_w.astype(jnp.float32)
    s_w = jnp.where(m_w, s_w, NEG)
    p_w = jax.nn.softmax(s_w, axis=-1)
    o_win = jnp.einsum('bghiqs,bisgd->bghiqd', p_w.astype(vw.dtype), vw).reshape(B, G, Hg, T, dk)

    gt = jax.nn.sigmoid(gates.astype(jnp.float32)).reshape(B, T, G, Hg, 3).transpose(0, 2, 3, 1, 4)
    o = gt[..., 0:1] * o_cmp + gt[..., 1:2] * o_slc + gt[..., 2:3] * o_win
    return o.transpose(0, 3, 1, 2, 4).reshape(B, T, Q_WIDTH).astype(q.dtype)


def peer_ffn(h, w_q, keys1, keys2, u_tab, v_tab):
    B, T, D = h.shape
    q = (h @ w_q).reshape(B, T, PEER_HEADS, PEER_QDIM)
    s1 = jnp.einsum('bthd,nd->bthn', q[..., :PEER_HALF], keys1).astype(jnp.float32)
    s2 = jnp.einsum('bthd,nd->bthn', q[..., PEER_HALF:], keys2).astype(jnp.float32)
    v1, i1 = lax.top_k(s1, PEER_TOPK)
    v2, i2 = lax.top_k(s2, PEER_TOPK)
    cand = (v1[..., :, None] + v2[..., None, :]).reshape(B, T, PEER_HEADS, PEER_TOPK * PEER_TOPK)
    vbest, ci = lax.top_k(cand, PEER_TOPK)
    e = jnp.take_along_axis(i1, ci // PEER_TOPK, axis=-1) * PEER_NKEYS \
        + jnp.take_along_axis(i2, ci % PEER_TOPK, axis=-1)
    g = jax.nn.softmax(vbest, axis=-1)
    n_tb = (B * T) // PEER_TOKEN_BLOCK
    n_sel = PEER_HEADS * PEER_TOPK
    xb = h.reshape(n_tb, PEER_TOKEN_BLOCK, D)
    eb = e.reshape(n_tb, PEER_TOKEN_BLOCK, n_sel)
    gb = g.reshape(n_tb, PEER_TOKEN_BLOCK, n_sel)

    def expert_block(args):
        xt, et, gt = args
        a = jnp.einsum('nd,nkd->nk', xt, u_tab[et]).astype(jnp.float32)
        coef = gt * jax.nn.gelu(a)
        return jnp.einsum('nk,nkd->nd', coef.astype(v_tab.dtype), v_tab[et])

    out = lax.map(expert_block, (xb, eb, gb))
    return out.reshape(B, T, D).astype(h.dtype)


def setup_inputs(seed: int = 0) -> dict:
    key = jax.random.key(seed)
    ks = jax.random.split(key, 24)
    f32 = jnp.float32
    L, D = DEPTH, D_MODEL

    def nrm(k, shape, scale):
        return jax.random.normal(k, shape, f32) * scale

    def gain(k, shape):
        return 1.0 + 0.02 * jax.random.normal(k, shape, f32)

    return {
        "x": nrm(ks[0], (BATCH, SEQ, D), 1.0),
        "p": nrm(ks[1], (DEPTH, BATCH, SEQ, PLE_DIM), 1.0),
        "norm_mix_g": gain(ks[2], (L, D)),
        "w_in": nrm(ks[3], (L, D, IN_WIDTH), D ** -0.5),
        "pool_w": nrm(ks[4], (L, POOL_GROUPS, POOL_GROUP_WIDTH, POOL_GROUP_WIDTH), POOL_GROUP_WIDTH ** -0.5),
        "pool_scale": gain(ks[5], (L, POOL_WIDTH)),
        "cmp_pos_k": nrm(ks[6], (L, CMP_BLOCK, HEAD_DIM), 0.02),
        "cmp_pos_v": nrm(ks[7], (L, CMP_BLOCK, HEAD_DIM), 0.02),
        "cmp_w_k": nrm(ks[8], (L, CMP_BLOCK * HEAD_DIM, HEAD_DIM), (CMP_BLOCK * HEAD_DIM) ** -0.5),
        "cmp_w_v": nrm(ks[9], (L, CMP_BLOCK * HEAD_DIM, HEAD_DIM), (CMP_BLOCK * HEAD_DIM) ** -0.5),
        "w_up_pool": nrm(ks[10], (L, POOL_WIDTH, D), POOL_WIDTH ** -0.5),
        "w_up_nsa": nrm(ks[11], (L, Q_WIDTH, D), Q_WIDTH ** -0.5),
        "w_out": nrm(ks[12], (L, D, D), D ** -0.5),
        "norm_ffn_g": gain(ks[13], (L, D)),
        "peer_w_q": nrm(ks[14], (L, D, PEER_HEADS * PEER_QDIM), D ** -0.5),
        "peer_keys1": nrm(ks[15], (L, PEER_NKEYS, PEER_HALF), PEER_HALF ** -0.5),
        "peer_keys2": nrm(ks[16], (L, PEER_NKEYS, PEER_HALF), PEER_HALF ** -0.5),
        "peer_u": nrm(ks[17], (L, PEER_N_EXPERTS, D), D ** -0.5),
        "peer_v": nrm(ks[18], (L, PEER_N_EXPERTS, D), PEER_HEADS ** -0.5),
        "norm_ple_g": gain(ks[19], (L, D)),
        "ple_w_gate": nrm(ks[20], (L, D, D), D ** -0.5),
        "ple_w_proj": nrm(ks[21], (L, PLE_DIM, D), PLE_DIM ** -0.5),
        "norm_final_g": gain(ks[22], (D,)),
    }


def reference(x, p, norm_mix_g, w_in, pool_w, pool_scale, cmp_pos_k, cmp_pos_v, cmp_w_k, cmp_w_v,
              w_up_pool, w_up_nsa, w_out, norm_ffn_g, peer_w_q, peer_keys1, peer_keys2, peer_u, peer_v,
              norm_ple_g, ple_w_gate, ple_w_proj, norm_final_g):
    B, T, _ = x.shape
    offsets = [int(o) for o in np.cumsum(IN_SPLITS)[:-1]]
    for i in range(DEPTH):
        h = rms_norm(x, norm_mix_g[i])
        z = h @ w_in[i]
        u_pool, q, kv, nsa_gates, gate_pool, gate_nsa = jnp.split(z, offsets, axis=-1)
        kv = kv.reshape(B, T, 6, N_KV_GROUPS, HEAD_DIM)
        pool_out = pool_mixer(u_pool, pool_w[i], pool_scale[i])
        nsa_out = nsa_attention(q, kv[:, :, 0], kv[:, :, 1], kv[:, :, 2], kv[:, :, 3], kv[:, :, 4], kv[:, :, 5],
                                nsa_gates, cmp_pos_k[i], cmp_pos_v[i], cmp_w_k[i], cmp_w_v[i])
        merged = jax.nn.sigmoid(gate_pool) * (pool_out.astype(x.dtype) @ w_up_pool[i]) \
            + jax.nn.sigmoid(gate_nsa) * (nsa_out @ w_up_nsa[i])
        x = x + merged.astype(x.dtype) @ w_out[i]
        h2 = rms_norm(x, norm_ffn_g[i])
        x = x + peer_ffn(h2, peer_w_q[i], peer_keys1[i], peer_keys2[i], peer_u[i], peer_v[i])
        r = rms_norm(x, norm_ple_g[i])
        x = x + (jax.nn.sigmoid(r @ ple_w_gate[i]) * (p[i] @ ple_w_proj[i])).astype(x.dtype)
    return rms_norm(x, norm_final_g)
```

```cpp
#include <hip/hip_runtime.h>
#include <cstdio>
#include <cstdint>

#ifndef MK_MULTI
#define MK_MULTI 1
#endif
#ifndef PE_UN
#define PE_UN 2
#endif

#define GAS __attribute__((address_space(1)))
#define LAS __attribute__((address_space(3)))
typedef unsigned short bf16_t;
typedef short bf16x8 __attribute__((ext_vector_type(8)));
typedef short s16x4 __attribute__((ext_vector_type(4)));
typedef float f32x4 __attribute__((ext_vector_type(4)));
typedef float f32x2 __attribute__((ext_vector_type(2)));
typedef float f32x16 __attribute__((ext_vector_type(16)));
typedef unsigned u32x4 __attribute__((ext_vector_type(4)));
typedef unsigned u32x2 __attribute__((ext_vector_type(2)));

constexpr int T = 8192, D = 4096;
constexpr int ZW = 15616;
constexpr int ZC_POOL = 0, ZC_Q = 2048, ZC_KV = 4096, ZC_G = 7168, ZC_GP = 7424, ZC_GN = 11520;
constexpr int IN_W = 15408;
constexpr int NTHREADS = 512, NWAVES = 8;
constexpr float RMS_EPS = 1e-6f;

constexpr size_t MiB = 1u << 20;
constexpr size_t WS_CTL = 0, CTL_ZERO_BYTES = 1 * MiB;
constexpr size_t WS_W_IN = 2 * MiB;
constexpr size_t WS_W_UPP = 124 * MiB;
constexpr size_t WS_W_UPN = 140 * MiB;
constexpr size_t WS_W_OUT = 156 * MiB;
constexpr size_t WS_W_PQ = 188 * MiB;
constexpr size_t WS_W_PG = 204 * MiB;
constexpr size_t WS_W_PP = 236 * MiB;
constexpr size_t WS_W_POOL = 238 * MiB;
constexpr size_t WS_W_CMP = 240 * MiB;
constexpr size_t WS_SMALL = 242 * MiB;
constexpr size_t WS_R1 = 244 * MiB;
constexpr size_t WS_X = 500 * MiB;
constexpr size_t WS_A = 628 * MiB;
constexpr size_t WS_B = 692 * MiB;
constexpr size_t WS_C = 756 * MiB;
constexpr size_t WS_D = 820 * MiB;
constexpr size_t WS_NSA = 884 * MiB;
constexpr size_t WS_ACMP = 916 * MiB;
constexpr size_t WS_HCMP = 932 * MiB;
constexpr size_t WS_KCVC = 940 * MiB;
constexpr size_t WS_PE = 942 * MiB;
constexpr size_t WS_PG = 946 * MiB;
constexpr size_t WS_PBF = 950 * MiB;
constexpr size_t WS_END = 954 * MiB;

constexpr int CW_BAR = 4096;

constexpr int LDS_BYTES = 147456;
constexpr int MISC_OFF = 131072 + 8192;

#define LDS_WAIT() asm volatile("s_waitcnt lgkmcnt(0)" ::: "memory")
#define VM_WAIT() asm volatile("s_waitcnt vmcnt(0)" ::: "memory")
__device__ __forceinline__ unsigned f2bf(float f) { unsigned u = __builtin_bit_cast(unsigned, f); return (u + 0x7fffu + ((u >> 16) & 1u)) >> 16; }
__device__ __forceinline__ unsigned pk2(float lo, float hi) { return f2bf(lo) | (f2bf(hi) << 16); }
__device__ __forceinline__ unsigned cvtpk(float lo, float hi) { unsigned r; asm volatile("v_cvt_pk_bf16_f32 %0, %1, %2" : "=v"(r) : "v"(lo), "v"(hi)); return r; }
__device__ __forceinline__ float bflo(unsigned u) { return __builtin_bit_cast(float, u << 16); }
__device__ __forceinline__ float bfhi(unsigned u) { return __builtin_bit_cast(float, u & 0xffff0000u); }
__device__ __forceinline__ float bf2f(bf16_t b) { return __builtin_bit_cast(float, (unsigned)b << 16); }
__device__ __forceinline__ float sigmoidf_(float x) { return __builtin_amdgcn_rcpf(1.f + __builtin_amdgcn_exp2f(-1.4426950408889634f * x)); }
__device__ __forceinline__ float wave_sum(float v) {
#pragma unroll
    for (int o = 1; o < 64; o <<= 1) v += __shfl_xor(v, o);
    return v;
}

#define XB_TMO      128
#define XB_XCNT(j)  (256  + 64 * (j))
#define XB_XSUB(j)  (1280 + 64 * (j))
#define XB_XGEN(j)  (2304 + 64 * (j))
#define XB_TOP      3328
#define XB_TOPGEN   3392
#define XCD_BAR_WORDS 3456
#define XB_SPIN_CAP (1u << 18)

__device__ __forceinline__ unsigned xb_ld(unsigned* p)              { return __hip_atomic_load(p, __ATOMIC_RELAXED, __HIP_MEMORY_SCOPE_AGENT); }
__device__ __forceinline__ unsigned xb_add(unsigned* p, unsigned v) { return __hip_atomic_fetch_add(p, v, __ATOMIC_RELAXED, __HIP_MEMORY_SCOPE_AGENT); }
__device__ __forceinline__ unsigned xb_xcc_id() { return (unsigned)__builtin_amdgcn_s_getreg((3 << 11) | 20) & 0xFu; }
#define XB_SPIN(cond, bar) do { unsigned _sp = 0; while (cond) { __builtin_amdgcn_s_sleep(1); \
    if ((++_sp & 255u) == 0u) { if (xb_ld(&(bar)[XB_TMO])) break; if (_sp > XB_SPIN_CAP) { atomicAdd(&(bar)[XB_TMO], 1u); break; } } } } while (0)

struct XcdBarrier { unsigned* bar; unsigned x; volatile LAS unsigned* st; };

__device__ __forceinline__ XcdBarrier xcd_barrier_post(unsigned* bar, volatile LAS unsigned* st) {
    XcdBarrier b; b.bar = bar; b.x = xb_xcc_id(); b.st = st;
    if (threadIdx.x == 0) (void)xb_add(&bar[XB_XCNT(b.x)], 1u);
    return b;
}
__device__ __forceinline__ void xcd_barrier_complete(unsigned* bar, unsigned x, unsigned& nloc, unsigned& nx) {
    const unsigned G = gridDim.x * gridDim.y * gridDim.z;
    unsigned sum, cnt, mine, sp = 0u;
    for (;;) {
        sum = 0u; cnt = 0u; mine = 0u;
#pragma unroll
        for (unsigned j = 0; j < 16; ++j) { const unsigned c = xb_ld(&bar[XB_XCNT(j)]); sum += c; cnt += (c > 0u) ? 1u : 0u; mine = (j == x) ? c : mine; }
        if (sum == G) break;
        __builtin_amdgcn_s_sleep(1);
        if ((++sp & 255u) == 0u) { if (xb_ld(&bar[XB_TMO])) break; if (sp > XB_SPIN_CAP) { atomicAdd(&bar[XB_TMO], 1u); break; } }
    }
    nloc = mine > 0u ? mine : 1u; nx = cnt > 0u ? cnt : 1u;
}
__device__ __forceinline__ void xcd_barrier(const XcdBarrier& b) {
    asm volatile("s_waitcnt vmcnt(0)" ::: "memory");
    __syncthreads();
    if (threadIdx.x == 0) {
        unsigned* bar = b.bar;
        __builtin_amdgcn_s_waitcnt(0);
        unsigned nloc = b.st[0], nx = b.st[1];
        if (nloc == 0u) { xcd_barrier_complete(bar, b.x, nloc, nx); b.st[0] = nloc; b.st[1] = nx; }
        const unsigned old = xb_add(&bar[XB_XSUB(b.x)], 1u);
        const unsigned gen = old / nloc;
        if (old + 1u == (gen + 1u) * nloc) {
            __builtin_amdgcn_fence(__ATOMIC_RELEASE, "agent");
            asm volatile("s_waitcnt vmcnt(0)" ::: "memory");
            const unsigned og = xb_add(&bar[XB_TOP], 1u);
            const unsigned tg = og / nx;
            if (og + 1u == (tg + 1u) * nx) xb_add(&bar[XB_TOPGEN], 1u);
            else XB_SPIN(xb_ld(&bar[XB_TOPGEN]) == tg, bar);
            __builtin_amdgcn_fence(__ATOMIC_ACQUIRE, "agent");
            xb_add(&bar[XB_XGEN(b.x)], 1u);
            asm volatile("s_waitcnt vmcnt(0)" ::: "memory");
        } else {
            XB_SPIN(xb_ld(&bar[XB_XGEN(b.x)]) == gen, bar);
            __builtin_amdgcn_fence(__ATOMIC_ACQUIRE, "agent");
            asm volatile("s_waitcnt vmcnt(0)" ::: "memory");
        }
    }
    __syncthreads();
}

namespace pg8 {
constexpr int BM = 256, BK = 64, HALF = 128, HTB = HALF * BK * 2, STAGE_BYTES = 8 * HTB, NXCD = 8, WGM = 8;
__host__ __device__ __forceinline__ int lds_byte(int r, int c) { const int st = (r >> 4) * 2 + (c >> 5), rr = r & 15, cc = c & 31, ob = rr * 64 + cc * 2; return st * 1024 + (ob ^ (((ob >> 9) & 1) << 5)); }
__host__ __device__ __forceinline__ void stage_rc(int b, int& R, int& C) { const int st = b / 1024, sb = b % 1024, swz = sb ^ (((sb >> 9) & 1) << 5); R = (st >> 1) * 16 + swz / 64; C = (st & 1) * 32 + (swz % 64) / 2; }
__host__ __device__ __forceinline__ int perm32(int rho) { const int n = rho >> 4, i = rho & 15; return 8 * (i >> 2) + 4 * n + (i & 3); }

struct Unit { int pm, pn; };
struct Gemm { const bf16_t* A; const bf16_t* Bt; int K, lda, ldb; };

template <int MODE> struct Order {
    int nM, nN, nwg, G, c;
    __device__ void init(int nM_, int nN_, int G_, int c_) { nM = nM_; nN = nN_; nwg = (MODE == 2) ? 16 : nM * nN; G = G_; c = c_; }
    __device__ bool next(int i, Unit& u) const {
        const long L = (long)i * G + c; if (L >= nwg) return false;
        if (MODE == 2) { u.pm = (int)L; u.pn = (int)L >> 3; return true; }
        int wgid = (int)L; { const int q = nwg / NXCD, r = nwg % NXCD, xcd = wgid % NXCD, off = wgid / NXCD; wgid = (xcd < r ? xcd * (q + 1) : r * (q + 1) + (xcd - r) * q) + off; }
        const int nig = WGM * nN, gid = wgid / nig, fm = gid * WGM, gsz = (nM - fm) < WGM ? (nM - fm) : WGM;
        u.pm = fm + ((wgid % nig) % gsz); u.pn = (wgid % nig) / gsz; return true;
    }
    __device__ __forceinline__ size_t a_off(const Unit& u, const Gemm& g) const { size_t o = (size_t)u.pm * BM * g.lda * 2; if (MODE == 1) o += (size_t)(u.pn >> 1) * 512 * 2; return o; }
    __device__ __forceinline__ size_t b_off(const Unit& u, const Gemm& g) const { return (size_t)u.pn * BM * g.ldb * 2; }
};

template <class Epi, class Sched>
__device__ __forceinline__ void gemm_phase(LAS unsigned char* lds, const Gemm g, const Sched& S, const Epi& E) {
    const int tid = threadIdx.x, wid = __builtin_amdgcn_readfirstlane(tid >> 6), lane = tid & 63, wr = wid >> 2, wc = wid & 3, fr = lane & 15, fq = lane >> 4;
    const int K = g.K, nt = K / BK;
    unsigned voffA[2], voffB[2];
#pragma unroll
    for (int i = 0; i < 2; ++i) { int R, C; stage_rc(tid * 16 + i * 8192, R, C); const int Rb = Epi::PERM ? ((R & ~31) + perm32(R & 31)) : R;
        voffA[i] = (unsigned)(R * g.lda + C) * 2u; voffB[i] = (unsigned)(Rb * g.ldb + C) * 2u; }
    const size_t kstep = (size_t)(BK * 2);
    const size_t hstepA = (size_t)HALF * g.lda * 2, hstepB = (size_t)HALF * g.ldb * 2;
    const unsigned ldsw = (unsigned)wid * 1024u;
    const int aoff = lds_byte(wr * 64 + fr, fq * 8), boff = lds_byte(wc * 32 + fr, fq * 8);
#define PG8_SA(b, h) (((b) * 2 + (h)) * HTB)
#define PG8_SB(b, h) ((4 + (b) * 2 + (h)) * HTB)
#define PG8_STAGE(bufoff, gbase, voff) do { _Pragma("unroll") for (int _i = 0; _i < 2; ++_i) \
        __builtin_amdgcn_global_load_lds((const unsigned*)((const char*)(gbase) + (voff)[_i]), (LAS unsigned*)(lds + (bufoff) + ldsw + _i * 8192), 16, 0, 0); } while (0)
#define PG8_LDA(dst, b, h) do { _Pragma("unroll") for (int m = 0; m < 4; ++m) _Pragma("unroll") for (int k = 0; k < 2; ++k) dst[m][k] = *(const LAS bf16x8*)(lds + PG8_SA(b, h) + aoff + m * 2048 + k * 1024); } while (0)
#define PG8_LDB(dst, b, h) do { _Pragma("unroll") for (int n = 0; n < 2; ++n) _Pragma("unroll") for (int k = 0; k < 2; ++k) dst[n][k] = *(const LAS bf16x8*)(lds + PG8_SB(b, h) + boff + n * 2048 + k * 1024); } while (0)
#define PG8_MMA(ai, bj, At, Bt) do { __builtin_amdgcn_s_setprio(1); _Pragma("unroll") for (int m = 0; m < 4; ++m) _Pragma("unroll") for (int n = 0; n < 2; ++n) _Pragma("unroll") for (int k = 0; k < 2; ++k) \
        acc[ai][bj][m][n] = __builtin_amdgcn_mfma_f32_16x16x32_bf16(Bt[n][k], At[m][k], acc[ai][bj][m][n], 0, 0, 0); __builtin_amdgcn_s_setprio(0); } while (0)
#define PG8_WAIT_V(n) asm volatile("s_waitcnt vmcnt(" #n ")" ::: "memory")
#define PG8_WAIT_L(n) asm volatile("s_waitcnt lgkmcnt(" #n ")" ::: "memory")
#define PG8_BAR __builtin_amdgcn_s_barrier()
#define PG8_SCHED __builtin_amdgcn_sched_barrier(0)
    Unit cur, nxt; int ui = 0;
    if (!S.next(0, cur)) return;
    f32x4 acc[2][2][4][2];
#pragma unroll
    for (int a = 0; a < 2; ++a)
#pragma unroll
        for (int b = 0; b < 2; ++b)
#pragma unroll
            for (int m = 0; m < 4; ++m)
#pragma unroll
                for (int n = 0; n < 2; ++n) acc[a][b][m][n] = (f32x4){0.f, 0.f, 0.f, 0.f};
    bf16x8 At[4][2], B0[2][2], B1[2][2];
    const char* cA = (const char*)g.A + S.a_off(cur, g); const char* cB = (const char*)g.Bt + S.b_off(cur, g);
    PG8_STAGE(PG8_SB(0, 0), cB, voffB); PG8_STAGE(PG8_SA(0, 0), cA, voffA); PG8_STAGE(PG8_SB(0, 1), cB + hstepB, voffB); PG8_STAGE(PG8_SA(0, 1), cA + hstepA, voffA);
    if (wr == 1) PG8_BAR;
    PG8_WAIT_V(4); PG8_BAR;
    PG8_STAGE(PG8_SB(1, 0), cB + kstep, voffB); PG8_STAGE(PG8_SA(1, 0), cA + kstep, voffA); PG8_STAGE(PG8_SB(1, 1), cB + hstepB + kstep, voffB);
    PG8_WAIT_V(6); PG8_BAR;
    for (;;) {
        const bool has_next = S.next(ui + 1, nxt);
        const char* nA = has_next ? (const char*)g.A + S.a_off(nxt, g) : cA; const char* nB = has_next ? (const char*)g.Bt + S.b_off(nxt, g) : cB;
        for (int t = 0; t < nt; t += 2) {
            const bool last = (t == nt - 2);
            const char* a1 = cA + (size_t)(t + 1) * kstep;
            const char* a2 = last ? nA : cA + (size_t)(t + 2) * kstep; const char* b2 = last ? nB : cB + (size_t)(t + 2) * kstep;
            const char* a3 = a2 + kstep; const char* b3 = b2 + kstep;
            PG8_LDB(B0, 0, 0); PG8_SCHED; PG8_LDA(At, 0, 0); PG8_STAGE(PG8_SA(1, 1), a1 + hstepA, voffA);
            PG8_WAIT_L(8); PG8_BAR; PG8_WAIT_L(0); PG8_MMA(0, 0, At, B0); PG8_BAR; PG8_SCHED;
            PG8_LDB(B1, 0, 1); PG8_STAGE(PG8_SB(0, 0), b2, voffB);
            PG8_BAR; PG8_WAIT_L(0); PG8_MMA(0, 1, At, B1); PG8_BAR;
            PG8_LDA(At, 0, 1); PG8_STAGE(PG8_SA(0, 0), a2, voffA);
            PG8_BAR; PG8_WAIT_L(0); PG8_MMA(1, 0, At, B0); PG8_BAR; PG8_SCHED;
            PG8_STAGE(PG8_SB(0, 1), b2 + hstepB, voffB);
            PG8_WAIT_V(6); PG8_BAR; PG8_MMA(1, 1, At, B1); PG8_BAR;
            PG8_LDB(B0, 1, 0); PG8_SCHED; PG8_LDA(At, 1, 0); PG8_STAGE(PG8_SA(0, 1), a2 + hstepA, voffA);
            PG8_WAIT_L(8); PG8_BAR; PG8_WAIT_L(0); PG8_MMA(0, 0, At, B0); PG8_BAR; PG8_SCHED;
            PG8_LDB(B1, 1, 1); PG8_STAGE(PG8_SB(1, 0), b3, voffB);
            PG8_BAR; PG8_WAIT_L(0); PG8_MMA(0, 1, At, B1); PG8_BAR;
            PG8_LDA(At, 1, 1); PG8_STAGE(PG8_SA(1, 0), a3, voffA);
            PG8_BAR; PG8_WAIT_L(0); PG8_MMA(1, 0, At, B0); PG8_BAR; PG8_SCHED;
            PG8_STAGE(PG8_SB(1, 1), b3 + hstepB, voffB);
            PG8_WAIT_V(6); PG8_BAR; PG8_MMA(1, 1, At, B1); PG8_BAR;
        }
        E(acc, cur, wr, wc, fr, fq);
        if (!has_next) break;
#pragma unroll
        for (int a = 0; a < 2; ++a)
#pragma unroll
            for (int b = 0; b < 2; ++b)
#pragma unroll
                for (int m = 0; m < 4; ++m)
#pragma unroll
                    for (int n = 0; n < 2; ++n) acc[a][b][m][n] = (f32x4){0.f, 0.f, 0.f, 0.f};
        cur = nxt; cA = nA; cB = nB; ++ui;
    }
    PG8_WAIT_V(0);
    if (wr == 0) PG8_BAR;
    PG8_BAR;
#undef PG8_SA
#undef PG8_SB
#undef PG8_STAGE
#undef PG8_LDA
#undef PG8_LDB
#undef PG8_MMA
#undef PG8_WAIT_V
#undef PG8_WAIT_L
#undef PG8_BAR
#undef PG8_SCHED
}

template <int MODE> struct EpiB {
    static constexpr bool PERM = true;
    bf16_t* O; int ldo; const float* colscale; const bf16_t* gate; int ldg; const bf16_t* aux; int ldaux;
    __device__ __forceinline__ void operator()(const f32x4 (&acc)[2][2][4][2], const Unit& u, int wr, int wc, int fr, int fq) const {
        const int row0 = u.pm * BM + wr * 64 + fr, col0 = u.pn * BM + wc * 32 + 8 * fq;
#pragma unroll
        for (int ai = 0; ai < 2; ++ai)
#pragma unroll
            for (int m = 0; m < 4; ++m) { const int row = row0 + ai * HALF + m * 16;
#pragma unroll
                for (int bj = 0; bj < 2; ++bj) { const int col = col0 + bj * HALF; f32x4 v0 = acc[ai][bj][m][0], v1 = acc[ai][bj][m][1];
                    if (MODE == 1) { const f32x4 s0 = *(const f32x4*)(colscale + col), s1 = *(const f32x4*)(colscale + col + 4); v0 = v0 * s0; v1 = v1 * s1; }
                    if (MODE == 2 || MODE == 3) { const u32x4 gq = *(const u32x4*)(gate + (size_t)row * ldg + col);
                        f32x4 g0 = {sigmoidf_(bflo(gq.x)), sigmoidf_(bfhi(gq.x)), sigmoidf_(bflo(gq.y)), sigmoidf_(bfhi(gq.y))};
                        f32x4 g1 = {sigmoidf_(bflo(gq.z)), sigmoidf_(bfhi(gq.z)), sigmoidf_(bflo(gq.w)), sigmoidf_(bfhi(gq.w))};
                        v0 = v0 * g0; v1 = v1 * g1;
                        if (MODE == 3) { const u32x4 aq = *(const u32x4*)(aux + (size_t)row * ldaux + col);
                            v0 = v0 + (f32x4){bflo(aq.x), bfhi(aq.x), bflo(aq.y), bfhi(aq.y)}; v1 = v1 + (f32x4){bflo(aq.z), bfhi(aq.z), bflo(aq.w), bfhi(aq.w)}; } }
                    u32x4 w; w.x = cvtpk(v0[0], v0[1]); w.y = cvtpk(v0[2], v0[3]); w.z = cvtpk(v1[0], v1[1]); w.w = cvtpk(v1[2], v1[3]);
                    *(u32x4*)(O + (size_t)row * ldo + col) = w; } }
    }
};
template <int MODE> struct EpiF {
    static constexpr bool PERM = false;
    float* C; int ldc; const float* res; const bf16_t* aux; int ldaux;
    __device__ __forceinline__ void operator()(const f32x4 (&acc)[2][2][4][2], const Unit& u, int wr, int wc, int fr, int fq) const {
        const int row0 = u.pm * BM + wr * 64 + fr, col0 = u.pn * BM + wc * 32 + 4 * fq;
#pragma unroll
        for (int ai = 0; ai < 2; ++ai)
#pragma unroll
            for (int m = 0; m < 4; ++m) { const int row = row0 + ai * HALF + m * 16;
#pragma unroll
                for (int bj = 0; bj < 2; ++bj)
#pragma unroll
                    for (int n = 0; n < 2; ++n) { const int col = col0 + bj * HALF + n * 16; f32x4 v = acc[ai][bj][m][n];
                        if (MODE == 1) v = v + *(const f32x4*)(res + (size_t)row * ldc + col);
                        if (MODE == 2) { const u32x2 aq = *(const u32x2*)(aux + (size_t)row * ldaux + col); const f32x4 c0 = *(const f32x4*)(C + (size_t)row * ldc + col);
                            v = c0 + (f32x4){sigmoidf_(v[0]) * bflo(aq.x), sigmoidf_(v[1]) * bfhi(aq.x), sigmoidf_(v[2]) * bflo(aq.y), sigmoidf_(v[3]) * bfhi(aq.y)}; }
                        *(f32x4*)(C + (size_t)row * ldc + col) = v; } }
    }
};
}

struct Args {
    const float* in[23];
    float* out; unsigned char* ws;
    int ph_lo, ph_hi;
};

struct Frame {
    LAS unsigned char* lds;
    int tid, lane, wave, G, bid;
};

__device__ __forceinline__ void transpose_item(const float* src, int ld_src, int ncols_valid, bf16_t* dst, int ld_dst, int nblk, LAS float* scr, int item, int lane) {
    const int kb = item / nblk, nb = item % nblk, k0 = 64 * kb, n0 = 32 * nb;
    const int nn = n0 + (lane & 31); const bool ok = nn < ncols_valid;
#pragma unroll 8
    for (int i = 0; i < 32; ++i) { const int kk = 2 * i + (lane >> 5); scr[kk * 33 + (lane & 31)] = ok ? src[(size_t)(k0 + kk) * ld_src + nn] : 0.f; }
    LDS_WAIT(); asm volatile("" ::: "memory");
    const int c = lane & 7;
#pragma unroll
    for (int j = 0; j < 4; ++j) { const int n = (lane >> 3) + 8 * j; const LAS float* s = scr + (8 * c) * 33 + n;
        u32x4 o; o.x = pk2(s[0 * 33], s[1 * 33]); o.y = pk2(s[2 * 33], s[3 * 33]); o.z = pk2(s[4 * 33], s[5 * 33]); o.w = pk2(s[6 * 33], s[7 * 33]);
        *(u32x4*)(dst + (size_t)(n0 + n) * ld_dst + k0 + 8 * c) = o; }
    LDS_WAIT(); asm volatile("" ::: "memory");
}
template <bool OUT_F32>
__device__ __forceinline__ void rms_row(const float* xrow, const float* gain, void* orow, int lane) {
    const f32x4* xr = (const f32x4*)xrow + lane; const f32x4* gr = (const f32x4*)gain + lane;
    f32x4 v[16]; float s = 0.f;
#pragma unroll
    for (int j = 0; j < 16; ++j) { v[j] = xr[64 * j]; s += (v[j].x * v[j].x + v[j].y * v[j].y) + (v[j].z * v[j].z + v[j].w * v[j].w); }
    const float rstd = 1.f / sqrtf(wave_sum(s) * (1.f / D) + RMS_EPS);
#pragma unroll
    for (int j = 0; j < 16; ++j) { const f32x4 g = gr[64 * j]; const f32x4 o = v[j] * rstd * g;
        if (OUT_F32) ((f32x4*)orow)[lane + 64 * j] = o;
        else ((u32x2*)orow)[lane + 64 * j] = (u32x2){pk2(o.x, o.y), pk2(o.z, o.w)}; }
}
__device__ __forceinline__ void cvt_stream(const float* src, bf16_t* dst, size_t n8, size_t gtid, size_t gthreads) {
    for (size_t i = gtid; i < n8; i += gthreads) { const f32x4 a = ((const f32x4*)src)[2 * i], b = ((const f32x4*)src)[2 * i + 1];
        ((u32x4*)dst)[i] = (u32x4){pk2(a.x, a.y), pk2(a.z, a.w), pk2(b.x, b.y), pk2(b.z, b.w)}; }
}

__device__ __forceinline__ void phase_prologue(const Frame& F, const Args& a) {
    unsigned char* ws = a.ws;
    LAS float* scr = (LAS float*)(F.lds + F.wave * 16384);
    const int gw = F.bid * NWAVES + F.wave, NGW = F.G * NWAVES;
    const float* w_in = a.in[3];
    struct TT { const float* src; int ld_src, nvalid; bf16_t* dst; int ld_dst, K, N; };
    for (int job = 0; job < 16; ++job) {
        TT t;
        switch (job) {
            case 0: t = {w_in, IN_W, 7216, (bf16_t*)(ws + WS_W_IN), D, D, 7424}; break;
            case 1: t = {w_in + 7216, IN_W, 8192, (bf16_t*)(ws + WS_W_IN) + (size_t)7424 * D, D, D, 8192}; break;
            case 2: t = {a.in[10], D, D, (bf16_t*)(ws + WS_W_UPP), 2048, 2048, D}; break;
            case 3: t = {a.in[11], D, D, (bf16_t*)(ws + WS_W_UPN), 2048, 2048, D}; break;
            case 4: t = {a.in[12], D, D, (bf16_t*)(ws + WS_W_OUT), D, D, D}; break;
            case 5: t = {a.in[14], 2048, 2048, (bf16_t*)(ws + WS_W_PQ), D, D, 2048}; break;
            case 6: t = {a.in[20], D, D, (bf16_t*)(ws + WS_W_PG), D, D, D}; break;
            case 7: t = {a.in[21], D, D, (bf16_t*)(ws + WS_W_PP), 256, 256, D}; break;
            case 8: case 9: case 10: case 11: { const int gi = job - 8; t = {a.in[4] + (size_t)gi * 512 * 512, 512, 512, (bf16_t*)(ws + WS_W_POOL) + (size_t)gi * 512 * 512, 512, 512, 512}; break; }
            default: { const int j = job - 12, kv = j >> 1, half = j & 1;
                t = {a.in[8 + kv] + (size_t)half * 2048 * 128, 128, 128, (bf16_t*)(ws + WS_W_CMP) + (size_t)(kv * 256 + half * 128) * 2048, 2048, 2048, 128}; break; }
        }
        const int nblk = t.N / 32, items = (t.K / 64) * nblk;
        for (int it = gw; it < items; it += NGW) transpose_item(t.src, t.ld_src, t.nvalid, t.dst, t.ld_dst, nblk, scr, it, F.lane);
    }
    for (int m = gw; m < T; m += NGW) rms_row<false>(a.in[0] + (size_t)m * D, a.in[2], (bf16_t*)(ws + WS_A) + (size_t)m * D, F.lane);
    const size_t gtid = (size_t)F.bid * NTHREADS + F.tid, gth = (size_t)F.G * NTHREADS;
    cvt_stream(a.in[1], (bf16_t*)(ws + WS_PBF), (size_t)T * 256 / 8, gtid, gth);
    cvt_stream(a.in[15], (bf16_t*)(ws + WS_SMALL + 4096), 128 * 128 / 8, gtid, gth);
    cvt_stream(a.in[16], (bf16_t*)(ws + WS_SMALL + 4096 + 32768), 128 * 128 / 8, gtid, gth);
    for (int j = gw; j < 256; j += NGW) { const int kv = j >> 7, c = j & 127; const float* pos = a.in[6 + kv]; const float* W = a.in[8 + kv]; float s = 0.f;
        for (int i = F.lane; i < 4096; i += 64) s += pos[i] * W[(size_t)i * 128 + c];
        s = wave_sum(s); if (F.lane == 0) ((float*)(ws + WS_SMALL))[j] = s; }
}

__device__ __forceinline__ void phase_pool_prep(const Frame& F, const Args& a) {
    unsigned char* ws = a.ws;
    const bf16_t* Z = (const bf16_t*)(ws + WS_R1);
    bf16_t* pooled = (bf16_t*)(ws + WS_A);
    const size_t gtid = (size_t)F.bid * NTHREADS + F.tid, gth = (size_t)F.G * NTHREADS;
    for (size_t i = gtid; i < (size_t)T * 256; i += gth) {
        const int t = (int)(i >> 8), c8 = (int)(i & 255), gi = c8 >> 6, w = 2 << gi;
        const int cnt = (t + 1 < w) ? (t + 1) : w;
        float s[8] = {0, 0, 0, 0, 0, 0, 0, 0}; u32x4 own = {0, 0, 0, 0};
        for (int k = 0; k < cnt; ++k) { const u32x4 q = *(const u32x4*)(Z + (size_t)(t - k) * ZW + ZC_POOL + c8 * 8); if (k == 0) own = q;
            s[0] += bflo(q.x); s[1] += bfhi(q.x); s[2] += bflo(q.y); s[3] += bfhi(q.y); s[4] += bflo(q.z); s[5] += bfhi(q.z); s[6] += bflo(q.w); s[7] += bfhi(q.w); }
        const float inv = 1.f / (float)cnt;
        u32x4 o; o.x = pk2(s[0] * inv - bflo(own.x), s[1] * inv - bfhi(own.x)); o.y = pk2(s[2] * inv - bflo(own.y), s[3] * inv - bfhi(own.y));
        o.z = pk2(s[4] * inv - bflo(own.z), s[5] * inv - bfhi(own.z)); o.w = pk2(s[6] * inv - bflo(own.w), s[7] * inv - bfhi(own.w));
        *(u32x4*)(pooled + (size_t)t * 2048 + c8 * 8) = o;
    }
    bf16_t* acmp = (bf16_t*)(ws + WS_ACMP);
    for (size_t i = gtid; i < (size_t)4096 * 256; i += gth) {
        const int row = (int)(i >> 8), ch = (int)(i & 255), kvg = row >> 9, j = row & 511, l = ch >> 4, d8 = ch & 15;
        *(u32x4*)(acmp + (size_t)row * 2048 + ch * 8) = *(const u32x4*)(Z + (size_t)(16 * j + l) * ZW + ZC_KV + kvg * 128 + d8 * 8);
    }
}


__device__ __forceinline__ void phase_cmp_combine(const Frame& F, const Args& a) {
    unsigned char* ws = a.ws; const float* H = (const float*)(ws + WS_HCMP); const float* bias = (const float*)(ws + WS_SMALL); bf16_t* kcvc = (bf16_t*)(ws + WS_KCVC);
    const size_t gtid = (size_t)F.bid * NTHREADS + F.tid, gth = (size_t)F.G * NTHREADS;
    for (size_t i = gtid; i < (size_t)2 * 4 * 512 * 128; i += gth) {
        const int c = (int)(i & 127), n = (int)((i >> 7) & 511), g = (int)((i >> 16) & 3), kv = (int)(i >> 18);
        float v = 0.f;
        if (n <= 510) { const size_t r = (size_t)kv * 2048 + g * 512 + n; v = H[r * 512 + kv * 256 + c] + H[(r + 1) * 512 + kv * 256 + 128 + c] + bias[kv * 128 + c]; }
        kcvc[i] = (bf16_t)f2bf(v);
    }
}

namespace at {
constexpr int SHM = 16384;
constexpr int L_V = 0, L_K = 32768, L_WS = 65536, L_IMP = L_WS + 2048, IMP_LD = 132, L_SEL = L_IMP + 64 * IMP_LD * 4, L_UNI = L_SEL + 1024, L_CNT = L_UNI + 16,
              L_LC = L_CNT + 16, L_LW = L_LC + 64, L_LS = L_LW + 64, L_END = L_LS + 132 * 4;
static_assert(L_END <= 131072, "attention LDS map");
constexpr float LOG2E = 1.4426950408889634f;
constexpr float CS = 0.088388347648318440f * 1.4426950408889634f;
#define KSWZ(row, colB) ((row) * 256 + ((colB) ^ (((row) & 7) << 4)))
#define SBAR() __builtin_amdgcn_sched_barrier(0)
__device__ __forceinline__ int crow(int r, int hi) { return (r & 3) + 8 * (r >> 2) + 4 * hi; }
__device__ __forceinline__ int v_st(int k, int c) { const int kk = (k & ~0xC) | ((k & 4) << 1) | ((k & 8) >> 1); return ((kk >> 3) * 4 + (c >> 5)) * 512 + ((kk & 7) * 32 + (c & 31)) * 2; }
__device__ __forceinline__ int v_rd_base(int lane) { return ((lane & 3) << 3) | (((lane >> 2) & 3) << 6) | (((lane >> 4) & 1) << 5) | (((lane >> 5) & 1) << 8); }
constexpr int v_rd_off(int d0, int ks, int half) { return d0 * 512 + ks * 4096 + half * 2048; }
template <int OFF> __device__ __forceinline__ s16x4 tr_read(int vb) { s16x4 r; asm volatile("ds_read_b64_tr_b16 %0, %1 offset:%2" : "=&v"(r) : "v"(vb), "i"(OFF) : "memory"); return r; }

__device__ __forceinline__ void qkt(f32x16& p0, f32x16& p1, const LAS char* Ks, const bf16x8 (&qr)[8], int r32, int hi) {
    p0 = f32x16{}; p1 = f32x16{};
#pragma unroll
    for (int d0 = 0; d0 < 8; ++d0) { const int cb = (d0 * 16 + hi * 8) * 2;
        const bf16x8 b0 = *(const LAS bf16x8*)(Ks + KSWZ(r32, cb));
        const bf16x8 b1 = *(const LAS bf16x8*)(Ks + KSWZ(32 + r32, cb));
        p0 = __builtin_amdgcn_mfma_f32_32x32x16_bf16(b0, qr[d0], p0, 0, 0, 0);
        p1 = __builtin_amdgcn_mfma_f32_32x32x16_bf16(b1, qr[d0], p1, 0, 0, 0); }
}
template <int D0> __device__ __forceinline__ void pv_one(f32x16& od, int vb, bf16x8 pa0, bf16x8 pa1, bf16x8 pa2, bf16x8 pa3) {
    const s16x4 l0 = tr_read<v_rd_off(D0, 0, 0)>(vb), h0 = tr_read<v_rd_off(D0, 0, 1)>(vb), l1 = tr_read<v_rd_off(D0, 1, 0)>(vb), h1 = tr_read<v_rd_off(D0, 1, 1)>(vb);
    const s16x4 l2 = tr_read<v_rd_off(D0, 2, 0)>(vb), h2 = tr_read<v_rd_off(D0, 2, 1)>(vb), l3 = tr_read<v_rd_off(D0, 3, 0)>(vb), h3 = tr_read<v_rd_off(D0, 3, 1)>(vb);
    asm volatile("s_waitcnt lgkmcnt(0)" ::: "memory"); SBAR();
#define PK(L, H) (bf16x8){L[0], L[1], L[2], L[3], H[0], H[1], H[2], H[3]}
    od = __builtin_amdgcn_mfma_f32_32x32x16_bf16(pa0, PK(l0, h0), od, 0, 0, 0);
    od = __builtin_amdgcn_mfma_f32_32x32x16_bf16(pa1, PK(l1, h1), od, 0, 0, 0);
    od = __builtin_amdgcn_mfma_f32_32x32x16_bf16(pa2, PK(l2, h2), od, 0, 0, 0);
    od = __builtin_amdgcn_mfma_f32_32x32x16_bf16(pa3, PK(l3, h3), od, 0, 0, 0);
#undef PK
}
template <int MODE>
__device__ __forceinline__ void bias_mask(f32x16& p0, f32x16& p1, int b, int t, int hi, float slope2, bool selbit) {
    const float base = (MODE == 0) ? (float)(t - 31 - 1024 * b - 64 * hi) : (float)(t - 64 * b - 4 * hi);
    const float nb = -slope2 * base;
#pragma unroll
    for (int r = 0; r < 16; ++r) {
        const int c0 = (r & 3) + 8 * (r >> 2), c1 = 32 + c0;
        const float k0 = (MODE == 0) ? 16.f * c0 : (float)c0, k1 = (MODE == 0) ? 16.f * c1 : (float)c1;
        const float d0 = base - k0, d1 = base - k1;
        bool v0 = d0 >= 0.f, v1 = d1 >= 0.f;
        if (MODE == 1) { v0 = v0 && selbit; v1 = v1 && selbit; }
        if (MODE == 2) { v0 = v0 && (d0 < 512.f); v1 = v1 && (d1 < 512.f); }
        const float s0 = fmaf(p0[r], CS, fmaf(slope2, k0, nb)), s1 = fmaf(p1[r], CS, fmaf(slope2, k1, nb));
        p0[r] = v0 ? s0 : -__builtin_inff(); p1[r] = v1 ? s1 : -__builtin_inff();
    }
}
__device__ __forceinline__ float swap_max(float v) { auto rr = __builtin_amdgcn_permlane32_swap(__float_as_uint(v), __float_as_uint(v), false, false); return fmaxf(__uint_as_float(rr[0]), __uint_as_float(rr[1])); }
__device__ __forceinline__ float swap_sum(float v) { auto rr = __builtin_amdgcn_permlane32_swap(__float_as_uint(v), __float_as_uint(v), false, false); return __uint_as_float(rr[0]) + __uint_as_float(rr[1]); }

struct Stg { bf16x8 vs0, vs1, ks0, ks1; };

template <int MODE>
__device__ __forceinline__ void flash(LAS char* lds, const bf16_t* Kb, const bf16_t* Vb, int ldk, const LAS int* list, int n, const bf16x8 (&qr)[8],
                                      f32x16 (&o)[4], float& m_reg, float& l_reg, int t, float slope2, unsigned m0, unsigned m1, unsigned m2, unsigned m3,
                                      int tid, int wid, int lane) {
    const int r32 = lane & 31, hi = lane >> 5;
    LAS char* V_lds = lds + L_V; LAS char* K_lds = lds + L_K;
    LAS float* al_l = (LAS float*)(lds + L_WS) + wid * 64 + 32;
    const int sr = tid >> 4, sc = (tid & 15) * 8, vst0 = v_st(sr, sc), vst1 = v_st(32 + sr, sc), kst0 = KSWZ(sr, sc * 2), kst1 = KSWZ(32 + sr, sc * 2);
    const int vb0 = (int)(unsigned)(size_t)V_lds + v_rd_base(lane);
#pragma unroll
    for (int d = 0; d < 4; ++d) o[d] = f32x16{};
    m_reg = -1e30f; l_reg = 0.f;
    if (n <= 0) return;
    Stg s;
#define SLOAD(bt) do { const size_t _k0 = (size_t)(bt) * 64; \
        s.vs0 = *(const bf16x8*)(Vb + (_k0 + sr) * ldk + sc); s.vs1 = *(const bf16x8*)(Vb + (_k0 + 32 + sr) * ldk + sc); \
        s.ks0 = *(const bf16x8*)(Kb + (_k0 + sr) * ldk + sc); s.ks1 = *(const bf16x8*)(Kb + (_k0 + 32 + sr) * ldk + sc); } while (0)
#define SWRITE(bf) do { *(LAS bf16x8*)(V_lds + (bf) * SHM + vst0) = s.vs0; *(LAS bf16x8*)(V_lds + (bf) * SHM + vst1) = s.vs1; \
        *(LAS bf16x8*)(K_lds + (bf) * SHM + kst0) = s.ks0; *(LAS bf16x8*)(K_lds + (bf) * SHM + kst1) = s.ks1; } while (0)
    int bcur = __builtin_amdgcn_readfirstlane(list[0]);
    SLOAD(bcur); VM_WAIT(); SWRITE(0); __syncthreads();
    for (int i = 0; i < n; ++i) {
        const int buf = i & 1;
        int bnext = 0;
        if (i + 1 < n) { bnext = __builtin_amdgcn_readfirstlane(list[i + 1]); SLOAD(bnext); }
        f32x16 p0, p1;
        qkt(p0, p1, K_lds + buf * SHM, qr, r32, hi);
        bool selbit = true;
        if (MODE == 1) { const unsigned mw = (bcur < 32) ? m0 : (bcur < 64) ? m1 : (bcur < 96) ? m2 : m3; selbit = (mw >> (bcur & 31)) & 1u; }
        bias_mask<MODE>(p0, p1, bcur, t, hi, slope2, selbit);
        float pmax = p0[0];
#pragma unroll
        for (int r = 1; r < 16; ++r) pmax = fmaxf(pmax, p0[r]);
#pragma unroll
        for (int r = 0; r < 16; ++r) pmax = fmaxf(pmax, p1[r]);
        pmax = swap_max(pmax);
        const float mn = fmaxf(m_reg, pmax);
        const float alpha = __builtin_amdgcn_exp2f(m_reg - mn);
        m_reg = mn;
        float ps = 0.f;
#pragma unroll
        for (int r = 0; r < 16; ++r) { p0[r] = __builtin_amdgcn_exp2f(p0[r] - mn); ps += p0[r]; }
#pragma unroll
        for (int r = 0; r < 16; ++r) { p1[r] = __builtin_amdgcn_exp2f(p1[r] - mn); ps += p1[r]; }
        ps = swap_sum(ps);
        l_reg = l_reg * alpha + ps;
        bf16x8 pa0, pa1, pa2, pa3;
#define PK4(P, BASE, OUT) do { unsigned a0 = cvtpk(P[BASE + 0], P[BASE + 1]), a1 = cvtpk(P[BASE + 2], P[BASE + 3]); \
        unsigned b0 = cvtpk(P[BASE + 4], P[BASE + 5]), b1 = cvtpk(P[BASE + 6], P[BASE + 7]); \
        auto r0 = __builtin_amdgcn_permlane32_swap(a0, b0, false, false); auto r1 = __builtin_amdgcn_permlane32_swap(a1, b1, false, false); \
        u32x4 w = {r0[0], r1[0], r0[1], r1[1]}; OUT = *reinterpret_cast<bf16x8*>(&w); } while (0)
        PK4(p0, 0, pa0); PK4(p0, 8, pa1); PK4(p1, 0, pa2); PK4(p1, 8, pa3);
#undef PK4
        if (__any(alpha < 1.f)) { if (hi == 0) al_l[r32] = alpha; LDS_WAIT();
#pragma unroll
            for (int r = 0; r < 16; ++r) { const float a = al_l[crow(r, hi)];
#pragma unroll
                for (int d = 0; d < 4; ++d) o[d][r] *= a; } }
        const int vb = vb0 + buf * SHM;
        pv_one<0>(o[0], vb, pa0, pa1, pa2, pa3); pv_one<1>(o[1], vb, pa0, pa1, pa2, pa3); pv_one<2>(o[2], vb, pa0, pa1, pa2, pa3); pv_one<3>(o[3], vb, pa0, pa1, pa2, pa3);
        if (i + 1 < n) { VM_WAIT(); SWRITE(buf ^ 1); }
        __syncthreads();
        bcur = bnext;
    }
#undef SLOAD
#undef SWRITE
}

template <int BR>
__device__ __forceinline__ void accum_branch(float* acc_g, bf16_t* out_g, const f32x16 (&o)[4], float fac, LAS float* li_l, int r32, int hi) {
    if (hi == 0) li_l[r32] = fac;
    LDS_WAIT();
#pragma unroll
    for (int r = 0; r < 16; ++r) { const int row = crow(r, hi); const float f = li_l[row]; const size_t off = (size_t)(row & 7) * 2048 + (row >> 3) * 128 + r32;
#pragma unroll
        for (int d = 0; d < 4; ++d) { float v = o[d][r] * f;
            if (BR > 0) v += acc_g[off + 32 * d];
            if (BR < 2) acc_g[off + 32 * d] = v; else out_g[off + 32 * d] = (bf16_t)f2bf(v); } }
    LDS_WAIT();
}

__device__ __forceinline__ void attn_unit(const Frame& F, unsigned char* ws, int g, int qt) {
    LAS char* lds = (LAS char*)F.lds;
    const int tid = F.tid, wid = F.wave, lane = F.lane, r32 = lane & 31, hi = lane >> 5;
    const bf16_t* Z = (const bf16_t*)(ws + WS_R1);
    LAS float* imp = (LAS float*)(lds + L_IMP); LAS unsigned* sel = (LAS unsigned*)(lds + L_SEL); LAS unsigned* uni = (LAS unsigned*)(lds + L_UNI);
    LAS int* cnt = (LAS int*)(lds + L_CNT); LAS int* LC = (LAS int*)(lds + L_LC); LAS int* LW = (LAS int*)(lds + L_LW); LAS int* LS = (LAS int*)(lds + L_LS);
    LAS float* li_l = (LAS float*)(lds + L_WS) + wid * 64;
    const int t0 = 64 * qt, cur = qt;
    __syncthreads();
    for (int i = tid; i < 64 * IMP_LD; i += NTHREADS) imp[i] = 0.f;
    if (tid < 4) uni[tid] = 0u;
    if (tid == 0) { const int nc = ((4 * qt + 2) >> 6) + 1; for (int i = 0; i < nc; ++i) LC[i] = i; cnt[0] = nc;
        const int b0 = qt > 8 ? qt - 8 : 0, nw = qt - b0 + 1; for (int i = 0; i < nw; ++i) LW[i] = b0 + i; cnt[2] = nw; }
    __syncthreads();
    const int hh = r32 >> 3, jt = r32 & 7, tl = 8 * wid + jt, t = t0 + tl, head = g * 4 + hh;
    bf16x8 qr[8];
    { const bf16_t* Qrow = Z + (size_t)t * ZW + ZC_Q + head * 128 + hi * 8;
#pragma unroll
      for (int d0 = 0; d0 < 8; ++d0) qr[d0] = *(const bf16x8*)(Qrow + d0 * 16); }
    const float slope2 = __builtin_amdgcn_exp2f(-0.5f * (float)(head + 1)) * LOG2E;
    const bf16_t* gz = Z + (size_t)t * ZW + ZC_G + head * 3;
    const float g_cmp = sigmoidf_(bf2f(gz[0])), g_slc = sigmoidf_(bf2f(gz[1])), g_win = sigmoidf_(bf2f(gz[2]));
    const int nc = cnt[0], nw = cnt[2];
    f32x16 o[4]; float m_reg, l_reg;
    float* acc_g = (float*)(ws + WS_B) + (size_t)(t0 + 8 * wid) * 2048 + (size_t)g * 512;
    bf16_t* out_g = (bf16_t*)(ws + WS_NSA) + (size_t)(t0 + 8 * wid) * 2048 + (size_t)g * 512;
    const bf16_t* kc = (const bf16_t*)(ws + WS_KCVC) + (size_t)g * 512 * 128; const bf16_t* vc = kc + (size_t)4 * 512 * 128;
    flash<0>(lds, kc, vc, 128, LC, nc, qr, o, m_reg, l_reg, t, slope2, 0u, 0u, 0u, 0u, tid, wid, lane);
    const float inv_lc = l_reg > 0.f ? 1.f / l_reg : 0.f;
    accum_branch<0>(acc_g, out_g, o, g_cmp * inv_lc, li_l, r32, hi);
    { const float m_c = m_reg;
      const int sr = tid >> 4, sc = (tid & 15) * 8, kst0 = KSWZ(sr, sc * 2), kst1 = KSWZ(32 + sr, sc * 2);
      LAS char* K_lds = lds + L_K;
      for (int i = 0; i < nc; ++i) {
        const bf16x8 ks0 = *(const bf16x8*)(kc + ((size_t)i * 64 + sr) * 128 + sc), ks1 = *(const bf16x8*)(kc + ((size_t)i * 64 + 32 + sr) * 128 + sc);
        __syncthreads();
        *(LAS bf16x8*)(K_lds + kst0) = ks0; *(LAS bf16x8*)(K_lds + kst1) = ks1;
        __syncthreads();
        f32x16 p0, p1;
        qkt(p0, p1, K_lds, qr, r32, hi);
        bias_mask<0>(p0, p1, i, t, hi, slope2, true);
#pragma unroll
        for (int r = 0; r < 16; ++r) { float v0 = __builtin_amdgcn_exp2f(p0[r] - m_c) * inv_lc, v1 = __builtin_amdgcn_exp2f(p1[r] - m_c) * inv_lc;
            v0 += __shfl_xor(v0, 8); v0 += __shfl_xor(v0, 16); v1 += __shfl_xor(v1, 8); v1 += __shfl_xor(v1, 16); p0[r] = v0; p1[r] = v1; }
        if (r32 < 8) {
            LAS float* row = imp + tl * IMP_LD + 16 * i + hi;
#pragma unroll
            for (int a4 = 0; a4 < 4; ++a4) {
                const float s0 = (p0[4 * a4] + p0[4 * a4 + 1]) + (p0[4 * a4 + 2] + p0[4 * a4 + 3]), s1 = (p1[4 * a4] + p1[4 * a4 + 1]) + (p1[4 * a4 + 2] + p1[4 * a4 + 3]);
                atomicAdd((float*)(row + 2 * a4), s0); atomicAdd((float*)(row + 2 * a4 + 8), s1);
                atomicAdd((float*)(row + 2 * a4 + 1), p0[4 * a4 + 3]); atomicAdd((float*)(row + 2 * a4 + 9), p1[4 * a4 + 3]); }
        }
      }
    }
    LDS_WAIT();
    for (int j = 0; j < 8; ++j) {
        const int tj = 8 * wid + j; const LAS float* row = imp + tj * IMP_LD;
        unsigned key0, key1;
        { const int kk = lane; const unsigned bits = __float_as_uint(row[kk]);
          key0 = (kk > cur) ? 0u : (kk == 0 || kk == cur || kk == cur - 1) ? (0xFFFFFF80u | (unsigned)(127 - kk)) : ((((bits >> 7) + 1u) << 7) | (unsigned)(127 - kk)); }
        { const int kk = lane + 64; const unsigned bits = __float_as_uint(row[kk]);
          key1 = (kk > cur) ? 0u : (kk == cur || kk == cur - 1) ? (0xFFFFFF80u | (unsigned)(127 - kk)) : ((((bits >> 7) + 1u) << 7) | (unsigned)(127 - kk)); }
        unsigned w0 = 0u, w1 = 0u, w2 = 0u, w3 = 0u;
        for (int it = 0; it < 16; ++it) {
            const unsigned M = __reduce_max_sync(~0ull, key0 > key1 ? key0 : key1);
            if (M == 0u) break;
            const unsigned kk = 127u - (M & 127u), bit = 1u << (kk & 31u);
            if (kk < 32u) w0 |= bit; else if (kk < 64u) w1 |= bit; else if (kk < 96u) w2 |= bit; else w3 |= bit;
            if (key0 == M) key0 = 0u; if (key1 == M) key1 = 0u;
        }
        if (lane == 0) { sel[tj * 4 + 0] = w0; sel[tj * 4 + 1] = w1; sel[tj * 4 + 2] = w2; sel[tj * 4 + 3] = w3;
            atomicOr((unsigned*)&uni[0], w0); atomicOr((unsigned*)&uni[1], w1); atomicOr((unsigned*)&uni[2], w2); atomicOr((unsigned*)&uni[3], w3); }
    }
    __syncthreads();
    if (tid == 0) { int n = 0; for (int b = 0; b <= cur; ++b) if ((uni[b >> 5] >> (b & 31)) & 1u) LS[n++] = b; cnt[1] = n; }
    __syncthreads();
    const int ns = cnt[1];
    const unsigned m0 = sel[tl * 4 + 0], m1 = sel[tl * 4 + 1], m2 = sel[tl * 4 + 2], m3 = sel[tl * 4 + 3];
    flash<1>(lds, Z + ZC_KV + (2 * 4 + g) * 128, Z + ZC_KV + (3 * 4 + g) * 128, ZW, LS, ns, qr, o, m_reg, l_reg, t, slope2, m0, m1, m2, m3, tid, wid, lane);
    accum_branch<1>(acc_g, out_g, o, l_reg > 0.f ? g_slc / l_reg : 0.f, li_l, r32, hi);
    flash<2>(lds, Z + ZC_KV + (4 * 4 + g) * 128, Z + ZC_KV + (5 * 4 + g) * 128, ZW, LW, nw, qr, o, m_reg, l_reg, t, slope2, 0u, 0u, 0u, 0u, tid, wid, lane);
    accum_branch<2>(acc_g, out_g, o, l_reg > 0.f ? g_win / l_reg : 0.f, li_l, r32, hi);
}
#undef KSWZ
#undef SBAR
}

__device__ __forceinline__ void phase_attention(const Frame& F, const Args& a) {
    for (int L = F.bid; L < 512; L += F.G) { const int g = L & 3, qt = (L < 256) ? 127 - (L >> 2) : ((L - 256) >> 2); at::attn_unit(F, a.ws, g, qt); }
}


namespace pk {
constexpr int SC_LD = 132;
__device__ __forceinline__ int crow(int r, int hi) { return (r & 3) + 8 * (r >> 2) + 4 * hi; }
__device__ __forceinline__ void score_tile(const Frame& F, unsigned char* ws, int tile) {
    LAS float* sc = (LAS float*)F.lds;
    const int tid = F.tid, wid = F.wave, lane = F.lane, r32 = lane & 31, hi = lane >> 5;
    const bf16_t* qp = (const bf16_t*)(ws + WS_B); const bf16_t* keys = (const bf16_t*)(ws + WS_SMALL + 4096);
    const int t0 = tile * 16;
    {
        const int side = wid >> 2, rho = 32 * (wid & 3) + r32, tl = rho >> 3, head = rho & 7;
        const bf16_t* qrow = qp + (size_t)(t0 + tl) * 2048 + head * 256 + side * 128 + hi * 8;
        bf16x8 qf[8];
#pragma unroll
        for (int d0 = 0; d0 < 8; ++d0) qf[d0] = *(const bf16x8*)(qrow + d0 * 16);
        const bf16_t* kb_ = keys + (size_t)side * 128 * 128 + (size_t)r32 * 128 + hi * 8;
        f32x16 acc[4];
#pragma unroll
        for (int kb = 0; kb < 4; ++kb) { acc[kb] = f32x16{};
#pragma unroll
            for (int d0 = 0; d0 < 8; ++d0) { const bf16x8 a = *(const bf16x8*)(kb_ + (size_t)kb * 32 * 128 + d0 * 16); acc[kb] = __builtin_amdgcn_mfma_f32_32x32x16_bf16(a, qf[d0], acc[kb], 0, 0, 0); } }
        LAS float* row = sc + (side * 128 + rho) * SC_LD;
#pragma unroll
        for (int kb = 0; kb < 4; ++kb)
#pragma unroll
            for (int a4 = 0; a4 < 4; ++a4) *(LAS f32x4*)(row + kb * 32 + 8 * a4 + 4 * hi) = (f32x4){acc[kb][4 * a4], acc[kb][4 * a4 + 1], acc[kb][4 * a4 + 2], acc[kb][4 * a4 + 3]};
    }
    __syncthreads();
    if (tid < 256) {
        LAS float* row = sc + tid * SC_LD;
        float val[16]; int idx[16];
#pragma unroll
        for (int i = 0; i < 16; ++i) { val[i] = -__builtin_inff(); idx[i] = 0; }
        for (int k = 0; k < 128; ++k) { float x = row[k]; int xi = k;
#pragma unroll
            for (int i = 0; i < 16; ++i) { const bool gt = x > val[i]; const float tv = gt ? val[i] : x; const int ti = gt ? idx[i] : xi; val[i] = gt ? x : val[i]; idx[i] = gt ? xi : idx[i]; x = tv; xi = ti; } }
#pragma unroll
        for (int i = 0; i < 16; ++i) { row[i] = val[i]; row[16 + i] = __int_as_float(idx[i]); }
    }
    __syncthreads();
    if (tid < 128) {
        const LAS float* r1 = sc + tid * SC_LD; const LAS float* r2 = sc + (128 + tid) * SC_LD;
        float v1[16], v2[16]; int i1[16], i2[16];
#pragma unroll
        for (int i = 0; i < 16; ++i) { v1[i] = r1[i]; i1[i] = __float_as_int(r1[16 + i]); v2[i] = r2[i]; i2[i] = __float_as_int(r2[16 + i]); }
        float val[16]; int ex[16];
#pragma unroll
        for (int i = 0; i < 16; ++i) { val[i] = -__builtin_inff(); ex[i] = 0; }
#pragma unroll
        for (int a = 0; a < 16; ++a)
#pragma unroll
            for (int b = 0; b < 16; ++b) if ((a + 1) * (b + 1) <= 16) { float x = v1[a] + v2[b]; int xi = i1[a] * 128 + i2[b];
#pragma unroll
                for (int i = 0; i < 16; ++i) { const bool gt = x > val[i]; const float tv = gt ? val[i] : x; const int ti = gt ? ex[i] : xi; val[i] = gt ? x : val[i]; ex[i] = gt ? xi : ex[i]; x = tv; xi = ti; } }
        float s = 0.f, gsm[16];
#pragma unroll
        for (int i = 0; i < 16; ++i) { gsm[i] = __builtin_amdgcn_exp2f((val[i] - val[0]) * 1.4426950408889634f); s += gsm[i]; }
        const float inv = 1.f / s;
        const int tl = tid >> 3, head = tid & 7;
        int* pe = (int*)(ws + WS_PE) + (size_t)(t0 + tl) * 128 + head * 16; float* pg = (float*)(ws + WS_PG) + (size_t)(t0 + tl) * 128 + head * 16;
#pragma unroll
        for (int i = 0; i < 16; ++i) { pe[i] = ex[i]; pg[i] = gsm[i] * inv; }
    }
    __syncthreads();
}
}
__device__ __forceinline__ void phase_peer_score(const Frame& F, const Args& a) { for (int tile = F.bid; tile < T / 16; tile += F.G) pk::score_tile(F, a.ws, tile); }

__device__ __forceinline__ float gelu_tanh(float a) {
    const float y = 0.7978845608028654f * (a + 0.044715f * a * a * a);
    const float th = 1.f - 2.f * __builtin_amdgcn_rcpf(1.f + __builtin_amdgcn_exp2f(2.8853900817779268f * y));
    return 0.5f * a * (1.f + th);
}
__device__ __forceinline__ float dot8(u32x4 w, u32x4 h, float s) {
    s = fmaf(bflo(w.x), bflo(h.x), s); s = fmaf(bfhi(w.x), bfhi(h.x), s); s = fmaf(bflo(w.y), bflo(h.y), s); s = fmaf(bfhi(w.y), bfhi(h.y), s);
    s = fmaf(bflo(w.z), bflo(h.z), s); s = fmaf(bfhi(w.z), bfhi(h.z), s); s = fmaf(bflo(w.w), bflo(h.w), s); s = fmaf(bfhi(w.w), bfhi(h.w), s); return s;
}
__device__ __forceinline__ void phase_peer_eval(const Frame& F, const Args& a) {
    unsigned char* ws = a.ws;
    const bf16_t* U = (const bf16_t*)(ws + WS_R1); const bf16_t* V = U + (size_t)16384 * 4096;
    const bf16_t* H2 = (const bf16_t*)(ws + WS_C); float* X = (float*)(ws + WS_X); bf16_t* R = (bf16_t*)(ws + WS_D);
    const int* PE = (const int*)(ws + WS_PE); const float* PG = (const float*)(ws + WS_PG); const float* gain = a.in[19];
    const int lane = F.lane, gw = F.bid * NWAVES + F.wave, NGW = F.G * NWAVES;
    for (int tok = gw; tok < T; tok += NGW) {
        u32x4 hreg[8];
#pragma unroll
        for (int c = 0; c < 8; ++c) hreg[c] = *(const u32x4*)(H2 + (size_t)tok * D + c * 512 + lane * 8);
        const int pe0 = PE[(size_t)tok * 128 + lane], pe1 = PE[(size_t)tok * 128 + 64 + lane];
        const float pg0 = PG[(size_t)tok * 128 + lane], pg1 = PG[(size_t)tok * 128 + 64 + lane];
        float cf0 = 0.f, cf1 = 0.f;
#pragma unroll
        for (int kh = 0; kh < 2; ++kh) {
            const int pev = kh ? pe1 : pe0; const float pgv = kh ? pg1 : pg0; float cf = 0.f;
            for (int k = 0; k < 64; k += PE_UN) {
                u32x4 w[PE_UN][8];
#pragma unroll
                for (int j = 0; j < PE_UN; ++j) { const int e = __builtin_amdgcn_readlane(pev, k + j); const bf16_t* ur = U + (size_t)e * D + lane * 8;
#pragma unroll
                    for (int c = 0; c < 8; ++c) w[j][c] = *(const u32x4*)(ur + c * 512); }
#pragma unroll
                for (int j = 0; j < PE_UN; ++j) { float s = 0.f;
#pragma unroll
                    for (int c = 0; c < 8; ++c) s = dot8(w[j][c], hreg[c], s);
                    s = wave_sum(s);
                    const float gk = __uint_as_float(__builtin_amdgcn_readlane(__float_as_uint(pgv), k + j));
                    const float co = gk * gelu_tanh(s);
                    cf = (lane == k + j) ? co : cf; }
            }
            if (kh) cf1 = cf; else cf0 = cf;
        }
        float acc[64];
#pragma unroll
        for (int i = 0; i < 64; ++i) acc[i] = 0.f;
#pragma unroll
        for (int kh = 0; kh < 2; ++kh) {
            const int pev = kh ? pe1 : pe0; const float cfv = kh ? cf1 : cf0;
            for (int k = 0; k < 64; k += PE_UN) {
                u32x4 w[PE_UN][8];
#pragma unroll
                for (int j = 0; j < PE_UN; ++j) { const int e = __builtin_amdgcn_readlane(pev, k + j); const bf16_t* vr = V + (size_t)e * D + lane * 8;
#pragma unroll
                    for (int c = 0; c < 8; ++c) w[j][c] = *(const u32x4*)(vr + c * 512); }
#pragma unroll
                for (int j = 0; j < PE_UN; ++j) { const float co = __uint_as_float(__builtin_amdgcn_readlane(__float_as_uint(cfv), k + j));
#pragma unroll
                    for (int c = 0; c < 8; ++c) { const u32x4 q = w[j][c];
                        acc[c * 8 + 0] = fmaf(co, bflo(q.x), acc[c * 8 + 0]); acc[c * 8 + 1] = fmaf(co, bfhi(q.x), acc[c * 8 + 1]);
                        acc[c * 8 + 2] = fmaf(co, bflo(q.y), acc[c * 8 + 2]); acc[c * 8 + 3] = fmaf(co, bfhi(q.y), acc[c * 8 + 3]);
                        acc[c * 8 + 4] = fmaf(co, bflo(q.z), acc[c * 8 + 4]); acc[c * 8 + 5] = fmaf(co, bfhi(q.z), acc[c * 8 + 5]);
                        acc[c * 8 + 6] = fmaf(co, bflo(q.w), acc[c * 8 + 6]); acc[c * 8 + 7] = fmaf(co, bfhi(q.w), acc[c * 8 + 7]); } }
            }
        }
        float ss = 0.f;
#pragma unroll
        for (int c = 0; c < 8; ++c) { float* xp = X + (size_t)tok * D + c * 512 + lane * 8; const f32x4 x0 = *(const f32x4*)xp, x1 = *(const f32x4*)(xp + 4);
            acc[c * 8 + 0] += x0.x; acc[c * 8 + 1] += x0.y; acc[c * 8 + 2] += x0.z; acc[c * 8 + 3] += x0.w; acc[c * 8 + 4] += x1.x; acc[c * 8 + 5] += x1.y; acc[c * 8 + 6] += x1.z; acc[c * 8 + 7] += x1.w;
            *(f32x4*)xp = (f32x4){acc[c * 8 + 0], acc[c * 8 + 1], acc[c * 8 + 2], acc[c * 8 + 3]}; *(f32x4*)(xp + 4) = (f32x4){acc[c * 8 + 4], acc[c * 8 + 5], acc[c * 8 + 6], acc[c * 8 + 7]};
#pragma unroll
            for (int i = 0; i < 8; ++i) ss = fmaf(acc[c * 8 + i], acc[c * 8 + i], ss); }
        const float rstd = 1.f / sqrtf(wave_sum(ss) * (1.f / D) + RMS_EPS);
#pragma unroll
        for (int c = 0; c < 8; ++c) { const float* gp = gain + c * 512 + lane * 8; const f32x4 g0 = *(const f32x4*)gp, g1 = *(const f32x4*)(gp + 4);
            u32x4 o; o.x = pk2(acc[c * 8 + 0] * rstd * g0.x, acc[c * 8 + 1] * rstd * g0.y); o.y = pk2(acc[c * 8 + 2] * rstd * g0.z, acc[c * 8 + 3] * rstd * g0.w);
            o.z = pk2(acc[c * 8 + 4] * rstd * g1.x, acc[c * 8 + 5] * rstd * g1.y); o.w = pk2(acc[c * 8 + 6] * rstd * g1.z, acc[c * 8 + 7] * rstd * g1.w);
            *(u32x4*)(R + (size_t)tok * D + c * 512 + lane * 8) = o; }
    }
}

template <bool OUT_F32>
__device__ __forceinline__ void phase_norm(const Frame& F, const float* X, const float* gain, void* out) {
    const int gw = F.bid * NWAVES + F.wave, NGW = F.G * NWAVES;
    for (int m = gw; m < T; m += NGW) rms_row<OUT_F32>(X + (size_t)m * D, gain, OUT_F32 ? (void*)((float*)out + (size_t)m * D) : (void*)((bf16_t*)out + (size_t)m * D), F.lane);
}

constexpr int NPH = 14;
__global__ void __launch_bounds__(NTHREADS, 2) fwd(Args args) {
    extern __shared__ __attribute__((aligned(16))) unsigned char lds_raw[];
    Frame F; F.lds = (LAS unsigned char*)lds_raw; F.tid = threadIdx.x; F.lane = F.tid & 63; F.wave = __builtin_amdgcn_readfirstlane(F.tid >> 6); F.G = gridDim.x; F.bid = blockIdx.x;
    volatile LAS unsigned* MISC = (volatile LAS unsigned*)(F.lds + MISC_OFF);
    if (F.tid < 32) MISC[F.tid] = 0u;
    __syncthreads();
    unsigned char* ws = args.ws;
    const int lo = args.ph_lo, hi = args.ph_hi;
    XcdBarrier bar; bar.bar = (unsigned*)(ws + WS_CTL) + CW_BAR; bar.x = 0; bar.st = MISC + 8;
    if (hi - lo > 1) bar = xcd_barrier_post((unsigned*)(ws + WS_CTL) + CW_BAR, MISC + 8);
#define IN(k) (lo <= (k) && (k) < hi)
#define SEAM(k) do { if (IN(k) && IN((k) + 1)) xcd_barrier(bar); } while (0)
    bf16_t* Z = (bf16_t*)(ws + WS_R1);

    if (IN(0)) { phase_prologue(F, args); SEAM(0); }
    if (IN(1)) {
        pg8::Gemm g{(const bf16_t*)(ws + WS_A), (const bf16_t*)(ws + WS_W_IN), D, D, D}; pg8::Order<0> S; S.init(T / 256, ZW / 256, F.G, F.bid);
        pg8::EpiB<0> E{Z, ZW, nullptr, nullptr, 0, nullptr, 0};
        pg8::gemm_phase(F.lds, g, S, E); SEAM(1); }
    if (IN(2)) { phase_pool_prep(F, args); SEAM(2); }
    if (IN(3)) {
        { pg8::Gemm g{(const bf16_t*)(ws + WS_A), (const bf16_t*)(ws + WS_W_POOL), 512, 2048, 512}; pg8::Order<1> S; S.init(T / 256, 8, F.G, F.bid);
          pg8::EpiB<1> E{(bf16_t*)(ws + WS_A) + (size_t)T * 2048, 2048, args.in[5], nullptr, 0, nullptr, 0};
          pg8::gemm_phase(F.lds, g, S, E); }
        { pg8::Gemm g{(const bf16_t*)(ws + WS_ACMP), (const bf16_t*)(ws + WS_W_CMP), 2048, 2048, 2048}; pg8::Order<2> S; S.init(16, 2, F.G, F.bid);
          pg8::EpiF<0> E{(float*)(ws + WS_HCMP), 512, nullptr, nullptr, 0};
          pg8::gemm_phase(F.lds, g, S, E); }
        SEAM(3); }
    if (IN(4)) {
        pg8::Gemm g{(const bf16_t*)(ws + WS_A) + (size_t)T * 2048, (const bf16_t*)(ws + WS_W_UPP), 2048, 2048, 2048}; pg8::Order<0> S; S.init(T / 256, D / 256, F.G, F.bid);
        pg8::EpiB<2> E{(bf16_t*)(ws + WS_C), D, nullptr, Z + ZC_GP, ZW, nullptr, 0};
        pg8::gemm_phase(F.lds, g, S, E); phase_cmp_combine(F, args); SEAM(4); }
    if (IN(5)) { phase_attention(F, args); SEAM(5); }
    if (IN(6)) {
        pg8::Gemm g{(const bf16_t*)(ws + WS_NSA), (const bf16_t*)(ws + WS_W_UPN), 2048, 2048, 2048}; pg8::Order<0> S; S.init(T / 256, D / 256, F.G, F.bid);
        pg8::EpiB<3> E{(bf16_t*)(ws + WS_D), D, nullptr, Z + ZC_GN, ZW, (const bf16_t*)(ws + WS_C), D};
        pg8::gemm_phase(F.lds, g, S, E); SEAM(6); }
    if (IN(7)) {
        pg8::Gemm g{(const bf16_t*)(ws + WS_D), (const bf16_t*)(ws + WS_W_OUT), D, D, D}; pg8::Order<0> S; S.init(T / 256, D / 256, F.G, F.bid);
        pg8::EpiF<1> E{(float*)(ws + WS_X), D, args.in[0], nullptr, 0};
        pg8::gemm_phase(F.lds, g, S, E); SEAM(7); }
    if (IN(8)) {
        phase_norm<false>(F, (const float*)(ws + WS_X), args.in[13], ws + WS_C);
        const size_t gtid = (size_t)F.bid * NTHREADS + F.tid, gth = (size_t)F.G * NTHREADS;
        cvt_stream(args.in[17], (bf16_t*)(ws + WS_R1), (size_t)16384 * 4096 / 8, gtid, gth);
        cvt_stream(args.in[18], (bf16_t*)(ws + WS_R1) + (size_t)16384 * 4096, (size_t)16384 * 4096 / 8, gtid, gth);
        SEAM(8); }
    if (IN(9)) {
        { pg8::Gemm g{(const bf16_t*)(ws + WS_C), (const bf16_t*)(ws + WS_W_PQ), D, D, D}; pg8::Order<0> S; S.init(T / 256, 2048 / 256, F.G, F.bid);
          pg8::EpiB<0> E{(bf16_t*)(ws + WS_B), 2048, nullptr, nullptr, 0, nullptr, 0};
          pg8::gemm_phase(F.lds, g, S, E); }
        { pg8::Gemm g{(const bf16_t*)(ws + WS_PBF), (const bf16_t*)(ws + WS_W_PP), 256, 256, 256}; pg8::Order<0> S; S.init(T / 256, D / 256, F.G, F.bid);
          pg8::EpiB<0> E{(bf16_t*)(ws + WS_A), D, nullptr, nullptr, 0, nullptr, 0};
          pg8::gemm_phase(F.lds, g, S, E); }
        SEAM(9); }
    if (IN(10)) { phase_peer_score(F, args); SEAM(10); }
    if (IN(11)) { phase_peer_eval(F, args); SEAM(11); }
    if (IN(12)) {
        pg8::Gemm g{(const bf16_t*)(ws + WS_D), (const bf16_t*)(ws + WS_W_PG), D, D, D}; pg8::Order<0> S; S.init(T / 256, D / 256, F.G, F.bid);
        pg8::EpiF<2> E{(float*)(ws + WS_X), D, nullptr, (const bf16_t*)(ws + WS_A), D};
        pg8::gemm_phase(F.lds, g, S, E); SEAM(12); }
    if (IN(13)) { phase_norm<true>(F, (const float*)(ws + WS_X), args.in[22], args.out); }
#undef IN
#undef SEAM
}

extern "C" void kernel_launch(void* const* d_in, const int* in_sizes, int n_in, void* d_out, int out_size, void* d_ws, size_t ws_size, hipStream_t stream) {
    static int grid = 0;
    if (grid == 0) {
        if (n_in != 23 || out_size != T * D || ws_size < WS_END) { fprintf(stderr, "kernel_launch: unexpected shapes n_in %d out %d ws %zu (need %zu)\n", n_in, out_size, ws_size, (size_t)WS_END); grid = -1; return; }
        int dev = 0, cus = 0, per_cu = 0;
        if (hipGetDevice(&dev) != hipSuccess || hipDeviceGetAttribute(&cus, hipDeviceAttributeMultiprocessorCount, dev) != hipSuccess) { grid = -1; return; }
        if (hipFuncSetAttribute((const void*)fwd, hipFuncAttributeMaxDynamicSharedMemorySize, LDS_BYTES) != hipSuccess) { fprintf(stderr, "kernel_launch: hipFuncSetAttribute failed\n"); grid = -1; return; }
        if (hipOccupancyMaxActiveBlocksPerMultiprocessor(&per_cu, (const void*)fwd, NTHREADS, LDS_BYTES) != hipSuccess || per_cu < 1) fprintf(stderr, "kernel_launch: occupancy query says %d\n", per_cu);
        (void)hipGetLastError();
        grid = cus;
    }
    if (grid < 0) return;
    hipMemsetAsync((char*)d_ws + WS_CTL, 0, CTL_ZERO_BYTES, stream);
    Args a{};
    for (int i = 0; i < 23; ++i) a.in[i] = (const float*)d_in[i];
    a.out = (float*)d_out; a.ws = (unsigned char*)d_ws;
#if MK_MULTI
    for (int ph = 0; ph < NPH; ++ph) { a.ph_lo = ph; a.ph_hi = ph + 1; hipLaunchKernelGGL(fwd, dim3(grid), dim3(NTHREADS), LDS_BYTES, stream, a); }
#else
    a.ph_lo = 0; a.ph_hi = NPH; hipLaunchKernelGGL(fwd, dim3(grid), dim3(NTHREADS), LDS_BYTES, stream, a);
#endif
}
```

```cpp
#include <hip/hip_runtime.h>
#include <cstdio>
#include <cstdint>

#ifndef MK_MULTI
#define MK_MULTI 0
#endif
#ifndef PROBE_DUP
#define PROBE_DUP -1
#endif
#define PT_SIDE_ROWS 16384
#ifndef PT_EARLY_ROWS
#define PT_EARLY_ROWS 12288
#endif
#ifndef PS_B
#define PS_B 32
#endif
#ifndef PE_UN
#define PE_UN 4
#endif

#define GAS __attribute__((address_space(1)))
#define LAS __attribute__((address_space(3)))
typedef unsigned short bf16_t;
typedef short bf16x8 __attribute__((ext_vector_type(8)));
typedef short s16x4 __attribute__((ext_vector_type(4)));
typedef float f32x4 __attribute__((ext_vector_type(4)));
typedef float f32x2 __attribute__((ext_vector_type(2)));
typedef float f32x16 __attribute__((ext_vector_type(16)));
typedef unsigned u32x4 __attribute__((ext_vector_type(4)));
typedef unsigned u32x2 __attribute__((ext_vector_type(2)));
typedef int i32x4 __attribute__((ext_vector_type(4)));

constexpr int T = 8192, D = 4096;
constexpr int ZW = 15616;
constexpr int ZC_POOL = 0, ZC_Q = 2048, ZC_KV = 4096, ZC_G = 7168, ZC_GP = 7424, ZC_GN = 11520;
constexpr int IN_W = 15408;
constexpr int NTHREADS = 512, NWAVES = 8;
constexpr float RMS_EPS = 1e-6f;

constexpr size_t MiB = 1u << 20;
constexpr size_t WS_CTL = 0, CTL_ZERO_BYTES = 1 * MiB;
constexpr size_t WS_W_IN = 2 * MiB;
constexpr size_t WS_W_UPP = 124 * MiB;
constexpr size_t WS_W_UPN = 140 * MiB;
constexpr size_t WS_W_OUT = 156 * MiB;
constexpr size_t WS_W_PQ = 188 * MiB;
constexpr size_t WS_W_PG = 204 * MiB;
constexpr size_t WS_W_PP = 236 * MiB;
constexpr size_t WS_W_POOL = 238 * MiB;
constexpr size_t WS_W_CMP = 240 * MiB;
constexpr size_t WS_SMALL = 242 * MiB;
constexpr size_t WS_R1 = 244 * MiB;
constexpr size_t WS_X = 500 * MiB;
constexpr size_t WS_XB = 244 * MiB + 64 * MiB;
constexpr size_t WS_A = 628 * MiB;
constexpr size_t WS_B = 692 * MiB;
constexpr size_t WS_C = 756 * MiB;
constexpr size_t WS_D = 820 * MiB;
constexpr size_t WS_NSA = 884 * MiB;
constexpr size_t WS_ACMP = 916 * MiB;
constexpr size_t WS_HCMP = 932 * MiB;
constexpr size_t WS_KCVC = 940 * MiB;
constexpr size_t WS_PE = 942 * MiB;
constexpr size_t WS_PG = 946 * MiB;
constexpr size_t WS_PBF = 950 * MiB;
constexpr size_t WS_PT = 954 * MiB;
constexpr size_t WS_END = 1083 * MiB;

constexpr int CW_BAR = 4096;

constexpr int LDS_BYTES = 147456;
constexpr int MISC_OFF = 131072 + 8192;

#define LDS_WAIT() asm volatile("s_waitcnt lgkmcnt(0)" ::: "memory")
#define VM_WAIT() asm volatile("s_waitcnt vmcnt(0)" ::: "memory")
__device__ __forceinline__ unsigned f2bf(float f) { unsigned u = __builtin_bit_cast(unsigned, f); return (u + 0x7fffu + ((u >> 16) & 1u)) >> 16; }
__device__ __forceinline__ unsigned pk2(float lo, float hi) { return f2bf(lo) | (f2bf(hi) << 16); }
__device__ __forceinline__ unsigned cvtpk(float lo, float hi) { unsigned r; asm volatile("v_cvt_pk_bf16_f32 %0, %1, %2" : "=v"(r) : "v"(lo), "v"(hi)); return r; }
__device__ __forceinline__ float bflo(unsigned u) { return __builtin_bit_cast(float, u << 16); }
__device__ __forceinline__ float bfhi(unsigned u) { return __builtin_bit_cast(float, u & 0xffff0000u); }
__device__ __forceinline__ float bf2f(bf16_t b) { return __builtin_bit_cast(float, (unsigned)b << 16); }
__device__ __forceinline__ float sigmoidf_(float x) { return __builtin_amdgcn_rcpf(1.f + __builtin_amdgcn_exp2f(-1.4426950408889634f * x)); }
__device__ __forceinline__ float wave_sum(float v) {
#pragma unroll
    for (int o = 1; o < 64; o <<= 1) v += __shfl_xor(v, o);
    return v;
}

#define XB_TMO      128
#define XB_XCNT(j)  (256  + 64 * (j))
#define XB_XSUB(j)  (1280 + 64 * (j))
#define XB_XGEN(j)  (2304 + 64 * (j))
#define XB_TOP      3328
#define XB_TOPGEN   3392
#define XCD_BAR_WORDS 3456
#define XB_SPIN_CAP (1u << 18)

__device__ __forceinline__ unsigned xb_ld(unsigned* p)              { return __hip_atomic_load(p, __ATOMIC_RELAXED, __HIP_MEMORY_SCOPE_AGENT); }
__device__ __forceinline__ unsigned xb_add(unsigned* p, unsigned v) { return __hip_atomic_fetch_add(p, v, __ATOMIC_RELAXED, __HIP_MEMORY_SCOPE_AGENT); }
__device__ __forceinline__ unsigned xb_xcc_id() { return (unsigned)__builtin_amdgcn_s_getreg((3 << 11) | 20) & 0xFu; }
#define XB_SPIN(cond, bar) do { unsigned _sp = 0; while (cond) { __builtin_amdgcn_s_sleep(1); \
    if ((++_sp & 255u) == 0u) { if (xb_ld(&(bar)[XB_TMO])) break; if (_sp > XB_SPIN_CAP) { atomicAdd(&(bar)[XB_TMO], 1u); break; } } } } while (0)

struct XcdBarrier { unsigned* bar; unsigned x; volatile LAS unsigned* st; };

__device__ __forceinline__ XcdBarrier xcd_barrier_post(unsigned* bar, volatile LAS unsigned* st) {
    XcdBarrier b; b.bar = bar; b.x = xb_xcc_id(); b.st = st;
    if (threadIdx.x == 0) (void)xb_add(&bar[XB_XCNT(b.x)], 1u);
    return b;
}
__device__ __forceinline__ void xcd_barrier_complete(unsigned* bar, unsigned x, unsigned& nloc, unsigned& nx) {
    const unsigned G = gridDim.x * gridDim.y * gridDim.z;
    unsigned sum, cnt, mine, sp = 0u;
    for (;;) {
        sum = 0u; cnt = 0u; mine = 0u;
#pragma unroll
        for (unsigned j = 0; j < 16; ++j) { const unsigned c = xb_ld(&bar[XB_XCNT(j)]); sum += c; cnt += (c > 0u) ? 1u : 0u; mine = (j == x) ? c : mine; }
        if (sum == G) break;
        __builtin_amdgcn_s_sleep(1);
        if ((++sp & 255u) == 0u) { if (xb_ld(&bar[XB_TMO])) break; if (sp > XB_SPIN_CAP) { atomicAdd(&bar[XB_TMO], 1u); break; } }
    }
    nloc = mine > 0u ? mine : 1u; nx = cnt > 0u ? cnt : 1u;
}
__device__ __forceinline__ void xcd_barrier(const XcdBarrier& b) {
    asm volatile("s_waitcnt vmcnt(0)" ::: "memory");
    __syncthreads();
    if (threadIdx.x == 0) {
        unsigned* bar = b.bar;
        __builtin_amdgcn_s_waitcnt(0);
        unsigned nloc = b.st[0], nx = b.st[1];
        if (nloc == 0u) { xcd_barrier_complete(bar, b.x, nloc, nx); b.st[0] = nloc; b.st[1] = nx; }
        const unsigned old = xb_add(&bar[XB_XSUB(b.x)], 1u);
        const unsigned gen = old / nloc;
        if (old + 1u == (gen + 1u) * nloc) {
            __builtin_amdgcn_fence(__ATOMIC_RELEASE, "agent");
            asm volatile("s_waitcnt vmcnt(0)" ::: "memory");
            const unsigned og = xb_add(&bar[XB_TOP], 1u);
            const unsigned tg = og / nx;
            if (og + 1u == (tg + 1u) * nx) xb_add(&bar[XB_TOPGEN], 1u);
            else XB_SPIN(xb_ld(&bar[XB_TOPGEN]) == tg, bar);
            __builtin_amdgcn_fence(__ATOMIC_ACQUIRE, "agent");
            xb_add(&bar[XB_XGEN(b.x)], 1u);
            asm volatile("s_waitcnt vmcnt(0)" ::: "memory");
        } else {
            XB_SPIN(xb_ld(&bar[XB_XGEN(b.x)]) == gen, bar);
            __builtin_amdgcn_fence(__ATOMIC_ACQUIRE, "agent");
            asm volatile("s_waitcnt vmcnt(0)" ::: "memory");
        }
    }
    __syncthreads();
}

namespace pg8 {
constexpr int BM = 256, BK = 64, HALF = 128, HTB = HALF * BK * 2, STAGE_BYTES = 8 * HTB, NXCD = 8, WGM = 8;
__host__ __device__ __forceinline__ int lds_byte(int r, int c) { const int st = (r >> 4) * 2 + (c >> 5), rr = r & 15, cc = c & 31, ob = rr * 64 + cc * 2; return st * 1024 + (ob ^ (((ob >> 9) & 1) << 5)); }
__host__ __device__ __forceinline__ void stage_rc(int b, int& R, int& C) { const int st = b / 1024, sb = b % 1024, swz = sb ^ (((sb >> 9) & 1) << 5); R = (st >> 1) * 16 + swz / 64; C = (st & 1) * 32 + (swz % 64) / 2; }
__host__ __device__ __forceinline__ int perm32(int rho) { const int n = rho >> 4, i = rho & 15; return 8 * (i >> 2) + 4 * n + (i & 3); }

struct Unit { int pm, pn; };
struct Gemm { const bf16_t* A; const bf16_t* Bt; int K, lda, ldb; };

template <int MODE> struct Order {
    int nM, nN, nwg, G, c;
    __device__ void init(int nM_, int nN_, int G_, int c_) { nM = nM_; nN = nN_; nwg = (MODE == 2) ? 16 : nM * nN; G = G_; c = c_; }
    __device__ bool next(int i, Unit& u) const {
        const long L = (long)i * G + c; if (L >= nwg) return false;
        if (MODE == 2) { u.pm = (int)L; u.pn = (int)L >> 3; return true; }
        int wgid = (int)L; { const int q = nwg / NXCD, r = nwg % NXCD, xcd = wgid % NXCD, off = wgid / NXCD; wgid = (xcd < r ? xcd * (q + 1) : r * (q + 1) + (xcd - r) * q) + off; }
        const int nig = WGM * nN, gid = wgid / nig, fm = gid * WGM, gsz = (nM - fm) < WGM ? (nM - fm) : WGM;
        u.pm = fm + ((wgid % nig) % gsz); u.pn = (wgid % nig) / gsz; return true;
    }
    __device__ __forceinline__ size_t a_off(const Unit& u, const Gemm& g) const { size_t o = (size_t)u.pm * BM * g.lda * 2; if (MODE == 1) o += (size_t)(u.pn >> 1) * 512 * 2; return o; }
    __device__ __forceinline__ size_t b_off(const Unit& u, const Gemm& g) const { return (size_t)u.pn * BM * g.ldb * 2; }
};

struct NoSide { static constexpr bool ON = false; __device__ void after(int) const {} };
template <class Epi, class Sched, bool ALIGN_EPI = true, bool SP2 = true, class Side = NoSide>
__device__ __forceinline__ void gemm_phase(LAS unsigned char* lds, const Gemm g, const Sched& S, const Epi& E, const Side side = Side()) {
    constexpr bool I8 = Epi::I8;
    const int tid = threadIdx.x, wid = __builtin_amdgcn_readfirstlane(tid >> 6), lane = tid & 63, wr = wid >> 2, wc = wid & 3, fr = lane & 15, fq = lane >> 4;
    const int K = g.K, nt = K / BK;
    unsigned voffA[2], voffB[2];
#pragma unroll
    for (int i = 0; i < 2; ++i) { int R, C; stage_rc(tid * 16 + i * 8192, R, C); const int Rb = Epi::PERM ? ((R & ~31) + perm32(R & 31)) : R;
        voffA[i] = (unsigned)(R * g.lda + C) * 2u; voffB[i] = (unsigned)(Rb * g.ldb + C) * 2u; }
    const size_t kstep = (size_t)(BK * 2);
    const size_t hstepA = (size_t)HALF * g.lda * 2, hstepB = (size_t)HALF * g.ldb * 2;
    const unsigned ldsw = (unsigned)wid * 1024u;
    const int aoff = lds_byte(wr * 64 + fr, fq * 8), boff = lds_byte(wc * 32 + fr, fq * 8);
#define PG8_SA(b, h) (((b) * 2 + (h)) * HTB)
#define PG8_SB(b, h) ((4 + (b) * 2 + (h)) * HTB)
#define PG8_STAGE(bufoff, gbase, voff) do { _Pragma("unroll") for (int _i = 0; _i < 2; ++_i) \
        __builtin_amdgcn_global_load_lds((const unsigned*)((const char*)(gbase) + (voff)[_i]), (LAS unsigned*)(lds + (bufoff) + ldsw + _i * 8192), 16, 0, 0); } while (0)
#define PG8_LDA(dst, b, h) do { _Pragma("unroll") for (int m = 0; m < 4; ++m) _Pragma("unroll") for (int k = 0; k < 2; ++k) dst[m][k] = *(const LAS bf16x8*)(lds + PG8_SA(b, h) + aoff + m * 2048 + k * 1024); } while (0)
#define PG8_LDB(dst, b, h) do { _Pragma("unroll") for (int n = 0; n < 2; ++n) _Pragma("unroll") for (int k = 0; k < 2; ++k) dst[n][k] = *(const LAS bf16x8*)(lds + PG8_SB(b, h) + boff + n * 2048 + k * 1024); } while (0)
#define PG8_MMA(ai, bj, At, Bt) do { __builtin_amdgcn_s_setprio(1); _Pragma("unroll") for (int m = 0; m < 4; ++m) _Pragma("unroll") for (int n = 0; n < 2; ++n) _Pragma("unroll") for (int k = 0; k < 2; ++k) { \
        if constexpr (I8) acc[ai][bj][m][n] = __builtin_bit_cast(f32x4, __builtin_amdgcn_mfma_i32_16x16x64_i8(__builtin_bit_cast(i32x4, Bt[n][k]), __builtin_bit_cast(i32x4, At[m][k]), __builtin_bit_cast(i32x4, acc[ai][bj][m][n]), 0, 0, 0)); \
        else acc[ai][bj][m][n] = __builtin_amdgcn_mfma_f32_16x16x32_bf16(Bt[n][k], At[m][k], acc[ai][bj][m][n], 0, 0, 0); } __builtin_amdgcn_s_setprio(0); } while (0)
#define PG8_WAIT_V(n) asm volatile("s_waitcnt vmcnt(" #n ")" ::: "memory")
#define PG8_WAIT_L(n) asm volatile("s_waitcnt lgkmcnt(" #n ")" ::: "memory")
#define PG8_BAR __builtin_amdgcn_s_barrier()
#define PG8_SCHED __builtin_amdgcn_sched_barrier(0)
    Unit cur, nxt; int ui = 0;
    if (!S.next(0, cur)) return;
    f32x4 acc[2][2][4][2];
#pragma unroll
    for (int a = 0; a < 2; ++a)
#pragma unroll
        for (int b = 0; b < 2; ++b)
#pragma unroll
            for (int m = 0; m < 4; ++m)
#pragma unroll
                for (int n = 0; n < 2; ++n) acc[a][b][m][n] = (f32x4){0.f, 0.f, 0.f, 0.f};
    bf16x8 At[4][2], B0[2][2], B1[2][2];
    const char* cA = (const char*)g.A + S.a_off(cur, g); const char* cB = (const char*)g.Bt + S.b_off(cur, g);
    if constexpr (SP2) {
        PG8_STAGE(PG8_SB(0, 0), cB, voffB); PG8_STAGE(PG8_SB(0, 1), cB + hstepB, voffB); PG8_STAGE(PG8_SA(0, 0), cA, voffA); PG8_STAGE(PG8_SA(0, 1), cA + hstepA, voffA);
        if (wr == 1) PG8_BAR;
        PG8_WAIT_V(2); PG8_BAR;
        PG8_STAGE(PG8_SB(1, 0), cB + kstep, voffB); PG8_STAGE(PG8_SA(1, 0), cA + kstep, voffA); PG8_STAGE(PG8_SB(1, 1), cB + hstepB + kstep, voffB);
        PG8_WAIT_V(6); PG8_BAR;
    } else {
        PG8_STAGE(PG8_SB(0, 0), cB, voffB); PG8_STAGE(PG8_SA(0, 0), cA, voffA); PG8_STAGE(PG8_SB(0, 1), cB + hstepB, voffB); PG8_STAGE(PG8_SA(0, 1), cA + hstepA, voffA);
        if (wr == 1) PG8_BAR;
        PG8_WAIT_V(4); PG8_BAR;
        PG8_STAGE(PG8_SB(1, 0), cB + kstep, voffB); PG8_STAGE(PG8_SA(1, 0), cA + kstep, voffA); PG8_STAGE(PG8_SB(1, 1), cB + hstepB + kstep, voffB);
        PG8_WAIT_V(6); PG8_BAR;
    }
    for (;;) {
        const bool has_next = S.next(ui + 1, nxt);
        const char* nA = has_next ? (const char*)g.A + S.a_off(nxt, g) : cA; const char* nB = has_next ? (const char*)g.Bt + S.b_off(nxt, g) : cB;
#pragma unroll 1
        for (int t = 0; t < nt; t += 2) {
            const bool last = (t == nt - 2);
            const char* a1 = cA + (size_t)(t + 1) * kstep;
            const char* a2 = last ? nA : cA + (size_t)(t + 2) * kstep; const char* b2 = last ? nB : cB + (size_t)(t + 2) * kstep;
            const char* a3 = a2 + kstep; const char* b3 = b2 + kstep;
            const bool after_epi = Epi::LOADS && t == 0 && ui > 0;
            if constexpr (SP2) {
            PG8_LDB(B0, 0, 0); PG8_LDB(B1, 0, 1); PG8_SCHED; PG8_LDA(At, 0, 0); PG8_STAGE(PG8_SA(1, 1), a1 + hstepA, voffA);
            if (!after_epi) PG8_WAIT_V(8);
            PG8_WAIT_L(0); PG8_BAR; PG8_MMA(0, 0, At, B0); PG8_MMA(0, 1, At, B1); PG8_BAR; PG8_SCHED;
            PG8_LDA(At, 0, 1); PG8_STAGE(PG8_SB(0, 0), b2, voffB); PG8_STAGE(PG8_SB(0, 1), b2 + hstepB, voffB); PG8_STAGE(PG8_SA(0, 0), a2, voffA);
            if (!after_epi) PG8_WAIT_V(8);
            PG8_WAIT_L(0); PG8_BAR; PG8_MMA(1, 0, At, B0); PG8_MMA(1, 1, At, B1); PG8_BAR; PG8_SCHED;
            PG8_LDB(B0, 1, 0); PG8_LDB(B1, 1, 1); PG8_SCHED; PG8_LDA(At, 1, 0); PG8_STAGE(PG8_SA(0, 1), a2 + hstepA, voffA);
            PG8_WAIT_V(8); PG8_WAIT_L(0); PG8_BAR; PG8_MMA(0, 0, At, B0); PG8_MMA(0, 1, At, B1); PG8_BAR; PG8_SCHED;
            PG8_LDA(At, 1, 1); PG8_STAGE(PG8_SB(1, 0), b3, voffB); PG8_STAGE(PG8_SB(1, 1), b3 + hstepB, voffB); PG8_STAGE(PG8_SA(1, 0), a3, voffA);
            PG8_WAIT_V(8); PG8_WAIT_L(0); PG8_BAR; PG8_MMA(1, 0, At, B0); PG8_MMA(1, 1, At, B1); PG8_BAR; PG8_SCHED;
            } else {
            PG8_LDB(B0, 0, 0); PG8_SCHED; PG8_LDA(At, 0, 0); PG8_STAGE(PG8_SA(1, 1), a1 + hstepA, voffA);
            PG8_WAIT_L(8); PG8_BAR; PG8_WAIT_L(0); PG8_MMA(0, 0, At, B0); PG8_BAR; PG8_SCHED;
            PG8_LDB(B1, 0, 1); PG8_STAGE(PG8_SB(0, 0), b2, voffB);
            PG8_BAR; PG8_WAIT_L(0); PG8_MMA(0, 1, At, B1); PG8_BAR;
            PG8_LDA(At, 0, 1); PG8_STAGE(PG8_SA(0, 0), a2, voffA);
            PG8_BAR; PG8_WAIT_L(0); PG8_MMA(1, 0, At, B0); PG8_BAR; PG8_SCHED;
            PG8_STAGE(PG8_SB(0, 1), b2 + hstepB, voffB);
            PG8_WAIT_V(6); PG8_BAR; PG8_MMA(1, 1, At, B1); PG8_BAR;
            PG8_LDB(B0, 1, 0); PG8_SCHED; PG8_LDA(At, 1, 0); PG8_STAGE(PG8_SA(0, 1), a2 + hstepA, voffA);
            PG8_WAIT_L(8); PG8_BAR; PG8_WAIT_L(0); PG8_MMA(0, 0, At, B0); PG8_BAR; PG8_SCHED;
            PG8_LDB(B1, 1, 1); PG8_STAGE(PG8_SB(1, 0), b3, voffB);
            PG8_BAR; PG8_WAIT_L(0); PG8_MMA(0, 1, At, B1); PG8_BAR;
            PG8_LDA(At, 1, 1); PG8_STAGE(PG8_SA(1, 0), a3, voffA);
            PG8_BAR; PG8_WAIT_L(0); PG8_MMA(1, 0, At, B0); PG8_BAR; PG8_SCHED;
            PG8_STAGE(PG8_SB(1, 1), b3 + hstepB, voffB);
            PG8_WAIT_V(6); PG8_BAR; PG8_MMA(1, 1, At, B1); PG8_BAR;
            }
        }
        if constexpr (ALIGN_EPI) { if (wr == 0) PG8_BAR; }
        E(acc, cur, wr, wc, fr, fq);
        if constexpr (Side::ON) side.after(ui);
        if (!has_next) break;
#pragma unroll
        for (int a = 0; a < 2; ++a)
#pragma unroll
            for (int b = 0; b < 2; ++b)
#pragma unroll
                for (int m = 0; m < 4; ++m)
#pragma unroll
                    for (int n = 0; n < 2; ++n) acc[a][b][m][n] = (f32x4){0.f, 0.f, 0.f, 0.f};
        cur = nxt; cA = nA; cB = nB; ++ui;
        if constexpr (ALIGN_EPI) { if (wr == 1) PG8_BAR; }
    }
    PG8_WAIT_V(0);
    if constexpr (!ALIGN_EPI) { if (wr == 0) PG8_BAR; }
    PG8_BAR;
#undef PG8_SA
#undef PG8_SB
#undef PG8_STAGE
#undef PG8_LDA
#undef PG8_LDB
#undef PG8_MMA
#undef PG8_WAIT_V
#undef PG8_WAIT_L
#undef PG8_BAR
#undef PG8_SCHED
}

template <int MODE, bool QI8 = false, bool RMAX = false> struct EpiB {
    static constexpr bool PERM = true, I8 = QI8, LOADS = QI8 || MODE != 0;
    const float* sa; const float* sb;
    bf16_t* O; int ldo; const float* colscale; const bf16_t* gate; int ldg; const bf16_t* aux; int ldaux; int sc_lo, sc_hi; float sc;
    unsigned* rowmax;
    __device__ __forceinline__ void operator()(const f32x4 (&acc)[2][2][4][2], const Unit& u, int wr, int wc, int fr, int fq) const {
        const int row0 = u.pm * BM + wr * 64 + fr, col0 = u.pn * BM + wc * 32 + 8 * fq;
        const float tsc = (MODE == 0 && u.pn >= sc_lo && u.pn < sc_hi) ? sc : 1.f;
        float ra[2][4]; f32x4 cb[2][2];
        if (QI8) {
#pragma unroll
            for (int ai = 0; ai < 2; ++ai)
#pragma unroll
                for (int m = 0; m < 4; ++m) ra[ai][m] = sa[row0 + ai * HALF + m * 16];
#pragma unroll
            for (int bj = 0; bj < 2; ++bj) { cb[bj][0] = *(const f32x4*)(sb + col0 + bj * HALF) * tsc; cb[bj][1] = *(const f32x4*)(sb + col0 + bj * HALF + 4) * tsc; } }
        else if (MODE == 1) {
#pragma unroll
            for (int bj = 0; bj < 2; ++bj) { cb[bj][0] = *(const f32x4*)(colscale + col0 + bj * HALF); cb[bj][1] = *(const f32x4*)(colscale + col0 + bj * HALF + 4); } }
        const bool dual = (MODE == 0) && aux != nullptr && u.pn >= ZC_KV / 256 && u.pn < ZC_KV / 256 + 4;
        u32x4 gq[2][2], aq[2][2]; f32x4 rs[2][2][2];
#define EPB_LOAD(k) do { if (MODE == 2 || MODE == 3 || MODE == 5) { _Pragma("unroll") for (int bj = 0; bj < 2; ++bj) { const int row_ = row0 + ((k) >> 2) * HALF + ((k) & 3) * 16, col_ = col0 + bj * HALF; \
            gq[(k) & 1][bj] = *(const u32x4*)(gate + (size_t)row_ * ldg + col_); if (MODE == 3 || MODE == 5) aq[(k) & 1][bj] = *(const u32x4*)(aux + (size_t)row_ * ldaux + col_); } } \
        if (MODE == 4) { _Pragma("unroll") for (int bj = 0; bj < 2; ++bj) { const float* rp_ = colscale + (size_t)(row0 + ((k) >> 2) * HALF + ((k) & 3) * 16) * ldg + col0 + bj * HALF; \
            rs[(k) & 1][bj][0] = *(const f32x4*)rp_; rs[(k) & 1][bj][1] = *(const f32x4*)(rp_ + 4); } } } while (0)
        EPB_LOAD(0);
#pragma unroll
        for (int kb = 0; kb < 8; ++kb) { const int ai = kb >> 2, m = kb & 3;
            if (kb < 7) EPB_LOAD(kb + 1);
            { const int row = row0 + ai * HALF + m * 16; float rmx = 0.f;
#pragma unroll
                for (int bj = 0; bj < 2; ++bj) { const int col = col0 + bj * HALF; f32x4 v0 = acc[ai][bj][m][0], v1 = acc[ai][bj][m][1];
                    if (QI8) { const f32x4 c0 = cb[bj][0] * ra[ai][m], c1 = cb[bj][1] * ra[ai][m]; const i32x4 i0 = __builtin_bit_cast(i32x4, v0), i1 = __builtin_bit_cast(i32x4, v1);
                        v0 = (f32x4){(float)i0[0], (float)i0[1], (float)i0[2], (float)i0[3]} * c0; v1 = (f32x4){(float)i1[0], (float)i1[1], (float)i1[2], (float)i1[3]} * c1; }
                    else if (MODE == 0) { v0 = v0 * tsc; v1 = v1 * tsc; }
                    if (!QI8 && MODE == 1) { v0 = v0 * cb[bj][0]; v1 = v1 * cb[bj][1]; }
                    if (MODE == 2 || MODE == 3) { const u32x4 g = gq[kb & 1][bj];
                        f32x4 g0 = {sigmoidf_(bflo(g.x)), sigmoidf_(bfhi(g.x)), sigmoidf_(bflo(g.y)), sigmoidf_(bfhi(g.y))};
                        f32x4 g1 = {sigmoidf_(bflo(g.z)), sigmoidf_(bfhi(g.z)), sigmoidf_(bflo(g.w)), sigmoidf_(bfhi(g.w))};
                        v0 = v0 * g0; v1 = v1 * g1;
                        if (MODE == 3) { const u32x4 q = aq[kb & 1][bj];
                            v0 = v0 + (f32x4){bflo(q.x), bfhi(q.x), bflo(q.y), bfhi(q.y)}; v1 = v1 + (f32x4){bflo(q.z), bfhi(q.z), bflo(q.w), bfhi(q.w)}; } }
                    if (MODE == 4) { v0 = v0 + rs[kb & 1][bj][0]; v1 = v1 + rs[kb & 1][bj][1]; }
                    if (MODE == 5) { const u32x4 c = gq[kb & 1][bj], q = aq[kb & 1][bj];
                        v0 = (f32x4){bflo(c.x) + sigmoidf_(v0[0]) * bflo(q.x), bfhi(c.x) + sigmoidf_(v0[1]) * bfhi(q.x), bflo(c.y) + sigmoidf_(v0[2]) * bflo(q.y), bfhi(c.y) + sigmoidf_(v0[3]) * bfhi(q.y)};
                        v1 = (f32x4){bflo(c.z) + sigmoidf_(v1[0]) * bflo(q.z), bfhi(c.z) + sigmoidf_(v1[1]) * bfhi(q.z), bflo(c.w) + sigmoidf_(v1[2]) * bflo(q.w), bfhi(c.w) + sigmoidf_(v1[3]) * bfhi(q.w)}; }
                    u32x4 w; w.x = cvtpk(v0[0], v0[1]); w.y = cvtpk(v0[2], v0[3]); w.z = cvtpk(v1[0], v1[1]); w.w = cvtpk(v1[2], v1[3]);
                    *(u32x4*)(O + (size_t)row * ldo + col) = w;
                    if (MODE == 0) { if (dual) { const int kc = col - ZC_KV;
                        *(u32x4*)((bf16_t*)aux + (size_t)((kc >> 7) * 512 + (row >> 4)) * 2048 + (row & 15) * 128 + (kc & 127)) = w; } }
                    if (RMAX) rmx = fmaxf(rmx, fmaxf(fmaxf(fmaxf(fabsf(bflo(w.x)), fabsf(bfhi(w.x))), fmaxf(fabsf(bflo(w.y)), fabsf(bfhi(w.y)))), fmaxf(fmaxf(fabsf(bflo(w.z)), fabsf(bfhi(w.z))), fmaxf(fabsf(bflo(w.w)), fabsf(bfhi(w.w)))))); }
                if (RMAX) { rmx = fmaxf(rmx, __shfl_xor(rmx, 16)); rmx = fmaxf(rmx, __shfl_xor(rmx, 32)); if (fq == 0) atomicMax(rowmax + row, __float_as_uint(rmx)); } } }
#undef EPB_LOAD
    }
};
template <int MODE, bool QI8 = false> struct EpiF {
    static constexpr bool PERM = false, I8 = QI8, LOADS = QI8 || MODE != 0;
    const float* sa; const float* sb;
    float* C; int ldc; const float* res; const bf16_t* aux; int ldaux;
    __device__ __forceinline__ void operator()(const f32x4 (&acc)[2][2][4][2], const Unit& u, int wr, int wc, int fr, int fq) const {
        const int row0 = u.pm * BM + wr * 64 + fr, col0 = u.pn * BM + wc * 32 + 4 * fq;
        float ra[2][4]; f32x4 cb[2][2];
        if (QI8) {
#pragma unroll
            for (int ai = 0; ai < 2; ++ai)
#pragma unroll
                for (int m = 0; m < 4; ++m) ra[ai][m] = sa[row0 + ai * HALF + m * 16];
#pragma unroll
            for (int bj = 0; bj < 2; ++bj)
#pragma unroll
                for (int n = 0; n < 2; ++n) cb[bj][n] = *(const f32x4*)(sb + col0 + bj * HALF + n * 16); }
        f32x4 rs[2][2][2]; u32x2 aq[2][2][2], cq[2][2][2];
#define EPF_LOAD(k) do { if (MODE == 1 || MODE == 5 || MODE == 4) { _Pragma("unroll") for (int bj = 0; bj < 2; ++bj) { _Pragma("unroll") for (int n = 0; n < 2; ++n) { \
            const int row_ = row0 + ((k) >> 2) * HALF + ((k) & 3) * 16, col_ = col0 + bj * HALF + n * 16; \
            if (MODE == 4) { aq[(k) & 1][bj][n] = *(const u32x2*)(aux + (size_t)row_ * ldaux + col_); cq[(k) & 1][bj][n] = *(const u32x2*)((const bf16_t*)C + (size_t)row_ * ldc + col_); } \
            else rs[(k) & 1][bj][n] = *(const f32x4*)(res + (size_t)row_ * ldc + col_); } } } } while (0)
        EPF_LOAD(0);
#pragma unroll
        for (int kb = 0; kb < 8; ++kb) { const int ai = kb >> 2, m = kb & 3;
            if (kb < 7) EPF_LOAD(kb + 1);
            { const int row = row0 + ai * HALF + m * 16;
#pragma unroll
                for (int bj = 0; bj < 2; ++bj)
#pragma unroll
                    for (int n = 0; n < 2; ++n) { const int col = col0 + bj * HALF + n * 16; f32x4 v = acc[ai][bj][m][n];
                        if (QI8) { const i32x4 iv = __builtin_bit_cast(i32x4, v); v = (f32x4){(float)iv[0], (float)iv[1], (float)iv[2], (float)iv[3]} * (cb[bj][n] * ra[ai][m]); }
                        if (MODE == 1 || MODE == 5) v = v + rs[kb & 1][bj][n];
                        if (MODE == 5) { *(u32x2*)((bf16_t*)aux + (size_t)row * ldaux + col) = (u32x2){cvtpk(v[0], v[1]), cvtpk(v[2], v[3])}; continue; }
                        if (MODE == 4) { const u32x2 a2 = aq[kb & 1][bj][n], c2 = cq[kb & 1][bj][n];
                            v = (f32x4){bflo(c2.x) + sigmoidf_(v[0]) * bflo(a2.x), bfhi(c2.x) + sigmoidf_(v[1]) * bfhi(a2.x), bflo(c2.y) + sigmoidf_(v[2]) * bflo(a2.y), bfhi(c2.y) + sigmoidf_(v[3]) * bfhi(a2.y)};
                            *(u32x2*)((bf16_t*)res + (size_t)row * ldc + col) = (u32x2){cvtpk(v[0], v[1]), cvtpk(v[2], v[3])}; continue; }
                        if (MODE == 2) { const u32x2 a2 = *(const u32x2*)(aux + (size_t)row * ldaux + col); const f32x4 c0 = *(const f32x4*)(C + (size_t)row * ldc + col);
                            v = c0 + (f32x4){sigmoidf_(v[0]) * bflo(a2.x), sigmoidf_(v[1]) * bfhi(a2.x), sigmoidf_(v[2]) * bflo(a2.y), sigmoidf_(v[3]) * bfhi(a2.y)}; }
                        if (MODE == 3) { const u32x2 a2 = *(const u32x2*)(aux + (size_t)row * ldaux + col); const f32x4 c0 = *(const f32x4*)(C + (size_t)row * ldc + col);
                            v = c0 + (f32x4){sigmoidf_(v[0]) * bflo(a2.x), sigmoidf_(v[1]) * bfhi(a2.x), sigmoidf_(v[2]) * bflo(a2.y), sigmoidf_(v[3]) * bfhi(a2.y)};
                            *(u32x2*)((bf16_t*)res + (size_t)row * ldc + col) = (u32x2){cvtpk(v[0], v[1]), cvtpk(v[2], v[3])}; }
                        else *(f32x4*)(C + (size_t)row * ldc + col) = v; } } }
#undef EPF_LOAD
    }
};
}

struct Args {
    const float* in[23];
    float* out; unsigned char* ws;
    int ph_lo, ph_hi;
};

struct Frame {
    LAS unsigned char* lds;
    int tid, lane, wave, G, bid;
    int vid;
};

__device__ __forceinline__ void transpose_item(const float* src, int ld_src, int nvalid, bf16_t* dst, int ld_dst, int nblk, int item, int lane) {
    const int kb = item / nblk, nb = item % nblk, nq = lane & 15, kg = lane >> 4, k = 32 * kb + 8 * kg, n = 64 * nb + 4 * nq;
    f32x4 v[8];
    const bool ok = n < nvalid;
#pragma unroll
    for (int i = 0; i < 8; ++i) v[i] = ok ? *(const f32x4*)(src + (size_t)(k + i) * ld_src + n) : (f32x4){0.f, 0.f, 0.f, 0.f};
#pragma unroll
    for (int jn = 0; jn < 4; ++jn) { u32x4 o; o.x = pk2(v[0][jn], v[1][jn]); o.y = pk2(v[2][jn], v[3][jn]); o.z = pk2(v[4][jn], v[5][jn]); o.w = pk2(v[6][jn], v[7][jn]);
        *(u32x4*)(dst + (size_t)(n + jn) * ld_dst + k) = o; }
}
template <bool OUT_F32>
__device__ __forceinline__ void rms_row(const float* xrow, const float* gain, void* orow, int lane) {
    const f32x4* xr = (const f32x4*)xrow + lane; const f32x4* gr = (const f32x4*)gain + lane;
    f32x4 v[16]; float s = 0.f;
#pragma unroll
    for (int j = 0; j < 16; ++j) { v[j] = xr[64 * j]; s += (v[j].x * v[j].x + v[j].y * v[j].y) + (v[j].z * v[j].z + v[j].w * v[j].w); }
    const float rstd = 1.f / sqrtf(wave_sum(s) * (1.f / D) + RMS_EPS);
#pragma unroll
    for (int j = 0; j < 16; ++j) { const f32x4 g = gr[64 * j]; const f32x4 o = v[j] * rstd * g;
        if (OUT_F32) ((f32x4*)orow)[lane + 64 * j] = o;
        else ((u32x2*)orow)[lane + 64 * j] = (u32x2){pk2(o.x, o.y), pk2(o.z, o.w)}; }
}
__device__ __forceinline__ void cvt_stream(const float* src, bf16_t* dst, size_t n8, size_t gtid, size_t gthreads) {
    for (size_t i = gtid; i < n8; i += gthreads) { const f32x4 a = ((const f32x4*)src)[2 * i], b = ((const f32x4*)src)[2 * i + 1];
        ((u32x4*)dst)[i] = (u32x4){pk2(a.x, a.y), pk2(a.z, a.w), pk2(b.x, b.y), pk2(b.z, b.w)}; }
}

__device__ __forceinline__ void rms_row_q(const float* xrow, const float* gain, bf16_t* orow, unsigned char* qrow, float* qscale, int lane) {
    const f32x4* xr = (const f32x4*)xrow + lane; const f32x4* gr = (const f32x4*)gain + lane;
    f32x4 v[16]; float s = 0.f;
#pragma unroll
    for (int j = 0; j < 16; ++j) { v[j] = xr[64 * j]; s += (v[j].x * v[j].x + v[j].y * v[j].y) + (v[j].z * v[j].z + v[j].w * v[j].w); }
    const float rstd = 1.f / sqrtf(wave_sum(s) * (1.f / D) + RMS_EPS);
    float amax = 0.f;
#pragma unroll
    for (int j = 0; j < 16; ++j) { const f32x4 g = gr[64 * j]; v[j] = v[j] * rstd * g; ((u32x2*)orow)[lane + 64 * j] = (u32x2){pk2(v[j].x, v[j].y), pk2(v[j].z, v[j].w)};
        amax = fmaxf(fmaxf(amax, fmaxf(fabsf(v[j].x), fabsf(v[j].y))), fmaxf(fabsf(v[j].z), fabsf(v[j].w))); }
    amax = fmaxf(amax, __shfl_xor(amax, 1)); amax = fmaxf(amax, __shfl_xor(amax, 2)); amax = fmaxf(amax, __shfl_xor(amax, 4));
    amax = fmaxf(amax, __shfl_xor(amax, 8)); amax = fmaxf(amax, __shfl_xor(amax, 16)); amax = fmaxf(amax, __shfl_xor(amax, 32));
    const float scale = amax > 0.f ? 127.f / amax : 0.f;
#pragma unroll
    for (int j = 0; j < 16; ++j) { const int ia = (int)__builtin_rintf(v[j].x * scale), ib = (int)__builtin_rintf(v[j].y * scale), ic = (int)__builtin_rintf(v[j].z * scale), id = (int)__builtin_rintf(v[j].w * scale);
        ((unsigned*)qrow)[lane + 64 * j] = ((unsigned)ia & 255u) | (((unsigned)ib & 255u) << 8) | (((unsigned)ic & 255u) << 16) | ((unsigned)id << 24); }
    if (lane == 0) *qscale = amax * (1.f / 127.f);
}

__device__ __forceinline__ unsigned pack_i8x4(float a, float b, float c, float d) {
    const int ia = (int)__builtin_rintf(a), ib = (int)__builtin_rintf(b), ic = (int)__builtin_rintf(c), id = (int)__builtin_rintf(d);
    return ((unsigned)ia & 255u) | (((unsigned)ib & 255u) << 8) | (((unsigned)ic & 255u) << 16) | ((unsigned)id << 24);
}
constexpr int CW_CMAX_IN = 16384, CW_CMAX_PG = 32768, CW_CMAX_OUT = 45056, CW_ROWMAX = 49152, CW_CMAX_PQ = 40960, CW_CMAX_UPP = 57344, CW_CMAX_UPN = 61440, CW_ROWMAX_P = 65536, CW_ROWMAX_N = 73728;
constexpr size_t SB_IN = WS_SMALL + 1048576, SB_PG = SB_IN + 65536, SA_H = SB_PG + 16384, SA_R = SA_H + 32768, SB_OUT = SA_R + 32768, SA_M = SB_OUT + 16384, SB_UPP = SA_M + 32768, SB_UPN = SB_UPP + 16384, SA_P = SB_UPN + 16384, SA_N = SA_P + 32768, SB_PQ = SA_N + 32768;
__device__ __forceinline__ void colmax_item(const float* src, int ld, int ncols, unsigned* cmax, int nblk, int item, int lane) {
    const int kb = item / nblk, nb = item % nblk, n = 256 * nb + 4 * lane;
    if (n >= ncols) return;
    f32x4 m = {0.f, 0.f, 0.f, 0.f};
#pragma unroll 16
    for (int i = 0; i < 64; ++i) { const f32x4 v = *(const f32x4*)(src + (size_t)(64 * kb + i) * ld + n); m.x = fmaxf(m.x, fabsf(v.x)); m.y = fmaxf(m.y, fabsf(v.y)); m.z = fmaxf(m.z, fabsf(v.z)); m.w = fmaxf(m.w, fabsf(v.w)); }
    atomicMax(cmax + n, __float_as_uint(m.x)); atomicMax(cmax + n + 1, __float_as_uint(m.y)); atomicMax(cmax + n + 2, __float_as_uint(m.z)); atomicMax(cmax + n + 3, __float_as_uint(m.w));
}
__device__ __forceinline__ void transpose_item_q(const float* src, int ld_src, int nvalid, unsigned char* dst, int ld_dst, const unsigned* cmax, float* sb, int nblk, int item, int lane) {
    const int kb = item / nblk, nb = item % nblk, nq = lane & 7, kg = lane >> 3, k = 128 * kb + 16 * kg, n = 32 * nb + 4 * nq;
    f32x4 v[16];
    const bool ok = n < nvalid;
#pragma unroll
    for (int i = 0; i < 16; ++i) v[i] = ok ? *(const f32x4*)(src + (size_t)(k + i) * ld_src + n) : (f32x4){0.f, 0.f, 0.f, 0.f};
#pragma unroll
    for (int jn = 0; jn < 4; ++jn) { const float amax = __uint_as_float(cmax[n + jn]), sc = amax > 0.f ? 127.f / amax : 0.f;
        u32x4 o; o.x = pack_i8x4(v[0][jn] * sc, v[1][jn] * sc, v[2][jn] * sc, v[3][jn] * sc); o.y = pack_i8x4(v[4][jn] * sc, v[5][jn] * sc, v[6][jn] * sc, v[7][jn] * sc);
        o.z = pack_i8x4(v[8][jn] * sc, v[9][jn] * sc, v[10][jn] * sc, v[11][jn] * sc); o.w = pack_i8x4(v[12][jn] * sc, v[13][jn] * sc, v[14][jn] * sc, v[15][jn] * sc);
        *(u32x4*)(dst + (size_t)(n + jn) * ld_dst + k) = o;
        if (kb == 0 && kg == 0) sb[n + jn] = amax * (1.f / 127.f); }
}
__device__ __forceinline__ void rms_row_i8(const float* xrow, const float* gain, unsigned char* qrow, float* qscale, int lane) {
    const f32x4* xr = (const f32x4*)xrow + lane; const f32x4* gr = (const f32x4*)gain + lane;
    f32x4 v[16]; float s = 0.f;
#pragma unroll
    for (int j = 0; j < 16; ++j) { v[j] = xr[64 * j]; s += (v[j].x * v[j].x + v[j].y * v[j].y) + (v[j].z * v[j].z + v[j].w * v[j].w); }
    const float rstd = 1.f / sqrtf(wave_sum(s) * (1.f / D) + RMS_EPS);
    float amax = 0.f;
#pragma unroll
    for (int j = 0; j < 16; ++j) { v[j] = v[j] * rstd * gr[64 * j]; amax = fmaxf(fmaxf(amax, fmaxf(fabsf(v[j].x), fabsf(v[j].y))), fmaxf(fabsf(v[j].z), fabsf(v[j].w))); }
#pragma unroll
    for (int o = 1; o < 64; o <<= 1) amax = fmaxf(amax, __shfl_xor(amax, o));
    const float scale = amax > 0.f ? 127.f / amax : 0.f;
#pragma unroll
    for (int j = 0; j < 16; ++j) ((unsigned*)qrow)[lane + 64 * j] = pack_i8x4(v[j].x * scale, v[j].y * scale, v[j].z * scale, v[j].w * scale);
    if (lane == 0) *qscale = amax * (1.f / 127.f);
}
__device__ __forceinline__ void rms_row_i8_b(const bf16_t* xrow, const float* gain, unsigned char* qrow, float* qscale, int lane) {
    const u32x2* xr = (const u32x2*)xrow + lane; const f32x4* gr = (const f32x4*)gain + lane;
    f32x4 v[16]; float s = 0.f;
#pragma unroll
    for (int j = 0; j < 16; ++j) { { const u32x2 q = xr[64 * j]; v[j] = (f32x4){bflo(q.x), bfhi(q.x), bflo(q.y), bfhi(q.y)}; } s += (v[j].x * v[j].x + v[j].y * v[j].y) + (v[j].z * v[j].z + v[j].w * v[j].w); }
    const float rstd = 1.f / sqrtf(wave_sum(s) * (1.f / D) + RMS_EPS);
    float amax = 0.f;
#pragma unroll
    for (int j = 0; j < 16; ++j) { v[j] = v[j] * rstd * gr[64 * j]; amax = fmaxf(fmaxf(amax, fmaxf(fabsf(v[j].x), fabsf(v[j].y))), fmaxf(fabsf(v[j].z), fabsf(v[j].w))); }
#pragma unroll
    for (int o = 1; o < 64; o <<= 1) amax = fmaxf(amax, __shfl_xor(amax, o));
    const float scale = amax > 0.f ? 127.f / amax : 0.f;
#pragma unroll
    for (int j = 0; j < 16; ++j) ((unsigned*)qrow)[lane + 64 * j] = pack_i8x4(v[j].x * scale, v[j].y * scale, v[j].z * scale, v[j].w * scale);
    if (lane == 0) *qscale = amax * (1.f / 127.f);
}

template <int NJ>
__device__ __forceinline__ void requant_rows(const Frame& F, const bf16_t* src, unsigned char* dst, const unsigned* rowmax, float* sa) {
    const int gw = F.bid * NWAVES + F.wave, NGW = F.G * NWAVES, lane = F.lane; constexpr int ncols = NJ * 512;
    for (int m0 = gw; m0 < T; m0 += 4 * NGW) { u32x4 q[4][NJ]; float am[4];
#pragma unroll
        for (int r = 0; r < 4; ++r) { const int m = (m0 + r * NGW < T) ? m0 + r * NGW : m0; am[r] = __uint_as_float(rowmax[m]); const u32x4* sp = (const u32x4*)(src + (size_t)m * ncols) + lane;
#pragma unroll
            for (int j = 0; j < NJ; ++j) q[r][j] = sp[64 * j]; }
#pragma unroll
        for (int r = 0; r < 4; ++r) { const int m = m0 + r * NGW;
            if (m < T) { const float sc = am[r] > 0.f ? 127.f / am[r] : 0.f; u32x2* dp = (u32x2*)(dst + (size_t)m * ncols) + lane;
#pragma unroll
                for (int j = 0; j < NJ; ++j) { const u32x4 qq = q[r][j];
                    dp[64 * j] = (u32x2){pack_i8x4(bflo(qq.x) * sc, bfhi(qq.x) * sc, bflo(qq.y) * sc, bfhi(qq.y) * sc), pack_i8x4(bflo(qq.z) * sc, bfhi(qq.z) * sc, bflo(qq.w) * sc, bfhi(qq.w) * sc)}; }
                if (lane == 0) sa[m] = am[r] * (1.f / 127.f); } } }
}

typedef __fp16 h16x2 __attribute__((ext_vector_type(2)));
template <int NCH>
__device__ __forceinline__ void quant_colblock(const Frame& F, const float* src, int ld_src, int nvalid, unsigned char* dst, int ld_dst, float* sb) {
    const int lane = F.lane, w = F.wave, nq = lane & 7, kg = lane >> 3, n = 4 * nq; constexpr int rows = NCH * 128, NREG = NCH < 2 ? NCH : 2;
    const bool ok = n < nvalid;
    LAS float* cm = (LAS float*)F.lds;
    LAS u32x4* hl = (LAS u32x4*)(F.lds + 4096) + F.tid;
    f32x4 m = {0.f, 0.f, 0.f, 0.f};
    unsigned h[NREG][16][2];
    const float* rb = src + (size_t)(w * rows) * ld_src;
    const unsigned loff = (unsigned)(16 * kg) * (unsigned)ld_src + (unsigned)n;
    f32x4 vb[2][8];
#pragma unroll
    for (int bt = 0; bt <= 2 * NCH; ++bt) {
        if (bt < 2 * NCH) {
#pragma unroll
            for (int i = 0; i < 8; ++i) vb[bt & 1][i] = *(const f32x4*)(rb + (size_t)((bt >> 1) * 128 + 8 * (bt & 1) + i) * ld_src + loff); }
        __builtin_amdgcn_sched_barrier(0);
        if (bt > 0) { const int pb = bt - 1, c = pb >> 1, hb = pb & 1; f32x4 (&v)[8] = vb[pb & 1]; unsigned t[8][2];
#pragma unroll
            for (int i = 0; i < 8; ++i) { v[i].x = ok ? v[i].x : 0.f; v[i].y = ok ? v[i].y : 0.f; v[i].z = ok ? v[i].z : 0.f; v[i].w = ok ? v[i].w : 0.f; }
#pragma unroll
            for (int i = 0; i < 8; ++i) { m.x = fmaxf(m.x, fabsf(v[i].x)); m.y = fmaxf(m.y, fabsf(v[i].y)); m.z = fmaxf(m.z, fabsf(v[i].z)); m.w = fmaxf(m.w, fabsf(v[i].w));
                t[i][0] = __builtin_bit_cast(unsigned, __builtin_amdgcn_cvt_pkrtz(v[i].x, v[i].y)); t[i][1] = __builtin_bit_cast(unsigned, __builtin_amdgcn_cvt_pkrtz(v[i].z, v[i].w)); }
            if (c < NREG) {
#pragma unroll
                for (int i = 0; i < 8; ++i) { h[c < NREG ? c : 0][8 * hb + i][0] = t[i][0]; h[c < NREG ? c : 0][8 * hb + i][1] = t[i][1]; } }
            else {
#pragma unroll
                for (int e = 0; e < 4; ++e) hl[((c - 2) * 8 + 4 * hb + e) * 512] = (u32x4){t[2 * e][0], t[2 * e][1], t[2 * e + 1][0], t[2 * e + 1][1]}; }
            __builtin_amdgcn_sched_barrier(0); } }
#pragma unroll
    for (int sh = 8; sh < 64; sh <<= 1) { m.x = fmaxf(m.x, __shfl_xor(m.x, sh)); m.y = fmaxf(m.y, __shfl_xor(m.y, sh)); m.z = fmaxf(m.z, __shfl_xor(m.z, sh)); m.w = fmaxf(m.w, __shfl_xor(m.w, sh)); }
    if (kg == 0) *(LAS f32x4*)(cm + w * 32 + n) = m;
    __syncthreads();
    f32x4 am = *(const LAS f32x4*)(cm + n);
#pragma unroll
    for (int ww = 1; ww < 8; ++ww) { const f32x4 t = *(const LAS f32x4*)(cm + ww * 32 + n); am.x = fmaxf(am.x, t.x); am.y = fmaxf(am.y, t.y); am.z = fmaxf(am.z, t.z); am.w = fmaxf(am.w, t.w); }
    f32x4 sc; sc.x = am.x > 0.f ? 127.f / am.x : 0.f; sc.y = am.y > 0.f ? 127.f / am.y : 0.f; sc.z = am.z > 0.f ? 127.f / am.z : 0.f; sc.w = am.w > 0.f ? 127.f / am.w : 0.f;
    if (w == 0 && kg == 0) *(f32x4*)(sb + n) = am * (1.f / 127.f);
    unsigned char* db = dst + w * rows;
    const unsigned doff = (unsigned)n * (unsigned)ld_dst + (unsigned)(16 * kg);
#pragma unroll
    for (int c = 0; c < NCH; ++c) { unsigned t[16][2];
        if (c < NREG) {
#pragma unroll
            for (int i = 0; i < 16; ++i) { t[i][0] = h[c < NREG ? c : 0][i][0]; t[i][1] = h[c < NREG ? c : 0][i][1]; } }
        else {
#pragma unroll
            for (int e = 0; e < 8; ++e) { const u32x4 q = hl[((c - 2) * 8 + e) * 512]; t[2 * e][0] = q.x; t[2 * e][1] = q.y; t[2 * e + 1][0] = q.z; t[2 * e + 1][1] = q.w; } }
#pragma unroll
        for (int jn = 0; jn < 4; ++jn) { const float s1 = sc[jn];
#define HV(i) ((float)__builtin_bit_cast(h16x2, t[i][jn >> 1])[jn & 1] * s1)
            u32x4 o; o.x = pack_i8x4(HV(0), HV(1), HV(2), HV(3)); o.y = pack_i8x4(HV(4), HV(5), HV(6), HV(7)); o.z = pack_i8x4(HV(8), HV(9), HV(10), HV(11)); o.w = pack_i8x4(HV(12), HV(13), HV(14), HV(15));
#undef HV
            *(u32x4*)(db + (size_t)(jn * ld_dst + c * 128) + doff) = o; }
        __builtin_amdgcn_sched_barrier(0); }
    __syncthreads();
}
__device__ __forceinline__ void phase_prologue(const Frame& F, const Args& a) {
    unsigned char* ws = a.ws;
    const int gw = F.bid * NWAVES + F.wave, NGW = F.G * NWAVES;
    const float* w_in = a.in[3];
    unsigned char* W8 = ws + WS_W_IN; float* sb_in = (float*)(ws + SB_IN);
    constexpr int B0 = 232, B1 = B0 + 256, B2 = B1 + 128, B3 = B2 + 128, NBIG = B3 + 64, NSMALL = 256;
    for (int bb = F.bid; bb < NBIG; bb += F.G) { const float* src; int ld, nv = 32; unsigned char* dst; float* sb;
        if (bb < B0) { src = w_in + 32 * bb; ld = IN_W; nv = 7216 - 32 * bb; dst = W8 + (size_t)32 * bb * D; sb = sb_in + 32 * bb; }
        else if (bb < B1) { const int b = bb - B0; src = w_in + 7216 + 32 * b; ld = IN_W; dst = W8 + (size_t)(7424 + 32 * b) * D; sb = sb_in + 7424 + 32 * b; }
        else if (bb < B2) { const int b = bb - B1; src = a.in[20] + 32 * b; ld = D; dst = ws + WS_W_PG + (size_t)32 * b * D; sb = (float*)(ws + SB_PG) + 32 * b; }
        else if (bb < B3) { const int b = bb - B2; src = a.in[12] + 32 * b; ld = D; dst = ws + WS_W_OUT + (size_t)32 * b * D; sb = (float*)(ws + SB_OUT) + 32 * b; }
        else { const int b = bb - B3; src = a.in[14] + 32 * b; ld = 2048; dst = ws + WS_W_PQ + (size_t)32 * b * D; sb = (float*)(ws + SB_PQ) + 32 * b; }
        quant_colblock<4>(F, src, ld, nv, dst, D, sb); }
    { const int rem = NBIG % F.G, span = (F.G > rem) ? F.G - rem : F.G, first = (F.G > rem) ? F.bid - rem : F.bid;
      if (first >= 0) for (int sblk = first; sblk < NSMALL; sblk += span) { const int b = sblk & 127, hi = sblk >> 7;
          quant_colblock<2>(F, a.in[10 + hi] + 32 * b, D, 32, ws + (hi ? WS_W_UPN : WS_W_UPP) + (size_t)32 * b * 2048, 2048, (float*)(ws + (hi ? SB_UPN : SB_UPP)) + 32 * b); } }
    { constexpr int J0 = 8 * 64, J1 = J0 + 4 * 128, J2 = J1 + 4 * 128;
      for (int it = gw; it < J2; it += NGW) {
          if (it < J0) transpose_item(a.in[21], D, D, (bf16_t*)(ws + WS_W_PP), 256, 64, it, F.lane);
          else if (it < J1) { const int gi = (it - J0) >> 7; transpose_item(a.in[4] + (size_t)gi * 512 * 512, 512, 512, (bf16_t*)(ws + WS_W_POOL) + (size_t)gi * 512 * 512, 512, 8, (it - J0) & 127, F.lane); }
          else { const int j = (it - J1) >> 7, kv = j >> 1, half = j & 1;
              transpose_item(a.in[8 + kv] + (size_t)half * 2048 * 128, 128, 128, (bf16_t*)(ws + WS_W_CMP) + (size_t)(kv * 256 + half * 128) * 2048, 2048, 2, (it - J1) & 127, F.lane); } } }
    const size_t gtid = (size_t)F.bid * NTHREADS + F.tid, gth = (size_t)F.G * NTHREADS;
    cvt_stream(a.in[1], (bf16_t*)(ws + WS_PBF), (size_t)T * 256 / 8, gtid, gth);
    cvt_stream(a.in[15], (bf16_t*)(ws + WS_SMALL + 4096), 128 * 128 / 8, gtid, gth);
    cvt_stream(a.in[16], (bf16_t*)(ws + WS_SMALL + 4096 + 32768), 128 * 128 / 8, gtid, gth);
    if (gw < 64) { const int kv = gw >> 5, w = gw & 31; const float* pos = a.in[6 + kv]; const float* W = a.in[8 + kv]; float s0 = 0.f, s1 = 0.f;
        for (int i0 = w * 128; i0 < w * 128 + 128; i0 += 16) { float pv[16], w0[16], w1[16];
#pragma unroll
            for (int j = 0; j < 16; ++j) { pv[j] = pos[i0 + j]; w0[j] = W[(size_t)(i0 + j) * 128 + F.lane]; w1[j] = W[(size_t)(i0 + j) * 128 + 64 + F.lane]; }
#pragma unroll
            for (int j = 0; j < 16; ++j) { s0 = fmaf(pv[j], w0[j], s0); s1 = fmaf(pv[j], w1[j], s1); } }
        float* part = (float*)(ws + WS_SMALL + 131072) + (size_t)gw * 128; part[F.lane] = s0; part[64 + F.lane] = s1; }
    { unsigned* ctr = (unsigned*)(ws + WS_CTL) + 3072; LAS unsigned* slot = (LAS unsigned*)(F.lds + 2048);
      for (;;) { if (F.tid == 0) *slot = xb_add(ctr, 1u);
          __syncthreads(); const int m0 = (int)*slot * 32; __syncthreads();
          if (m0 >= T) break;
          for (int j = 0; j < 4; ++j) { const int m = m0 + 4 * F.wave + j; rms_row_i8(a.in[0] + (size_t)m * D, a.in[2], ws + WS_A + (size_t)m * D, (float*)(ws + SA_H) + m, F.lane); } } }
}

__device__ __forceinline__ void phase_pool_prep(const Frame& F, const Args& a) {
    unsigned char* ws = a.ws;
    const bf16_t* Z = (const bf16_t*)(ws + WS_R1);
    bf16_t* pooled = (bf16_t*)(ws + WS_A);
    const size_t gtid = (size_t)F.bid * NTHREADS + F.tid, gth = (size_t)F.G * NTHREADS;
    if (gtid < 256) { const int kv = (int)(gtid >> 7), c = (int)(gtid & 127); const float* part = (const float*)(ws + WS_SMALL + 131072) + (size_t)kv * 32 * 128 + c; float sb = 0.f;
        for (int w = 0; w < 32; ++w) sb += part[w * 128];
        ((float*)(ws + WS_SMALL))[gtid] = sb; }
    for (size_t i = gtid; i < (size_t)T * 256; i += gth) {
        const int t = (int)(i >> 8), c8 = (int)(i & 255), gi = c8 >> 6;
        const bf16_t* zp = Z + (size_t)t * ZW + ZC_POOL + c8 * 8;
        float s[8] = {0, 0, 0, 0, 0, 0, 0, 0}; u32x4 own = *(const u32x4*)zp; int cnt = 1;
#define POOL_WIN(W) do { u32x4 q[W]; _Pragma("unroll") for (int k = 0; k < W; ++k) q[k] = (k == 0) ? own : ((t - k >= 0) ? *(const u32x4*)(zp - (size_t)k * ZW) : (u32x4){0u, 0u, 0u, 0u}); \
            _Pragma("unroll") for (int k = 0; k < W; ++k) { s[0] += bflo(q[k].x); s[1] += bfhi(q[k].x); s[2] += bflo(q[k].y); s[3] += bfhi(q[k].y); s[4] += bflo(q[k].z); s[5] += bfhi(q[k].z); s[6] += bflo(q[k].w); s[7] += bfhi(q[k].w); } \
            cnt = (t + 1 < W) ? (t + 1) : W; } while (0)
        if (gi == 0) POOL_WIN(2); else if (gi == 1) POOL_WIN(4); else if (gi == 2) POOL_WIN(8); else POOL_WIN(16);
#undef POOL_WIN
        const float inv = 1.f / (float)cnt;
        u32x4 o; o.x = pk2(s[0] * inv - bflo(own.x), s[1] * inv - bfhi(own.x)); o.y = pk2(s[2] * inv - bflo(own.y), s[3] * inv - bfhi(own.y));
        o.z = pk2(s[4] * inv - bflo(own.z), s[5] * inv - bfhi(own.z)); o.w = pk2(s[6] * inv - bflo(own.w), s[7] * inv - bfhi(own.w));
        *(u32x4*)(pooled + (size_t)t * 2048 + c8 * 8) = o;
    }
    bf16_t* acmp = (bf16_t*)(ws + WS_ACMP);
    for (size_t i = gtid; i < (size_t)4096 * 256; i += gth) {
        const int row = (int)(i >> 8), ch = (int)(i & 255), kvg = row >> 9, j = row & 511, l = ch >> 4, d8 = ch & 15;
        *(u32x4*)(acmp + (size_t)row * 2048 + ch * 8) = *(const u32x4*)(Z + (size_t)(16 * j + l) * ZW + ZC_KV + kvg * 128 + d8 * 8);
    }
}


__device__ __forceinline__ void pool_window_rows(const Frame& F, const bf16_t* Y, unsigned char* dst, float* sa) {
    const int gw = F.bid * NWAVES + F.wave, NGW = F.G * NWAVES, lane = F.lane;
    for (int t = gw; t < T; t += NGW) {
        float o[4][8]; float amax = 0.f;
#define PW_GROUP(gi, W) do { const bf16_t* yp = Y + (size_t)t * 2048 + (gi) * 512 + lane * 8; u32x4 q[W]; \
            _Pragma("unroll") for (int k = 0; k < W; ++k) q[k] = (t - k >= 0) ? *(const u32x4*)(yp - (size_t)k * 2048) : (u32x4){0u, 0u, 0u, 0u}; \
            float s[8] = {0, 0, 0, 0, 0, 0, 0, 0}; \
            _Pragma("unroll") for (int k = 0; k < W; ++k) { s[0] += bflo(q[k].x); s[1] += bfhi(q[k].x); s[2] += bflo(q[k].y); s[3] += bfhi(q[k].y); s[4] += bflo(q[k].z); s[5] += bfhi(q[k].z); s[6] += bflo(q[k].w); s[7] += bfhi(q[k].w); } \
            const float inv = 1.f / (float)((t + 1 < W) ? (t + 1) : W); \
            o[gi][0] = s[0] * inv - bflo(q[0].x); o[gi][1] = s[1] * inv - bfhi(q[0].x); o[gi][2] = s[2] * inv - bflo(q[0].y); o[gi][3] = s[3] * inv - bfhi(q[0].y); \
            o[gi][4] = s[4] * inv - bflo(q[0].z); o[gi][5] = s[5] * inv - bfhi(q[0].z); o[gi][6] = s[6] * inv - bflo(q[0].w); o[gi][7] = s[7] * inv - bfhi(q[0].w); \
            _Pragma("unroll") for (int i = 0; i < 8; ++i) amax = fmaxf(amax, fabsf(o[gi][i])); } while (0)
        PW_GROUP(0, 2); PW_GROUP(1, 4); PW_GROUP(2, 8); PW_GROUP(3, 16);
#undef PW_GROUP
#pragma unroll
        for (int sh = 1; sh < 64; sh <<= 1) amax = fmaxf(amax, __shfl_xor(amax, sh));
        const float scale = amax > 0.f ? 127.f / amax : 0.f;
#pragma unroll
        for (int gi = 0; gi < 4; ++gi) ((u32x2*)(dst + (size_t)t * 2048 + gi * 512))[lane] =
            (u32x2){pack_i8x4(o[gi][0] * scale, o[gi][1] * scale, o[gi][2] * scale, o[gi][3] * scale), pack_i8x4(o[gi][4] * scale, o[gi][5] * scale, o[gi][6] * scale, o[gi][7] * scale)};
        if (lane == 0) sa[t] = amax * (1.f / 127.f);
    }
}

__device__ __forceinline__ void phase_cmp_combine(const Frame& F, const Args& a) {
    unsigned char* ws = a.ws; const float* H = (const float*)(ws + WS_HCMP); const float* bias = (const float*)(ws + WS_SMALL); bf16_t* kcvc = (bf16_t*)(ws + WS_KCVC);
    const size_t gtid = (size_t)F.bid * NTHREADS + F.tid, gth = (size_t)F.G * NTHREADS;
    for (size_t i = gtid; i < (size_t)2 * 4 * 512 * 128; i += gth) {
        const int c = (int)(i & 127), n = (int)((i >> 7) & 511), g = (int)((i >> 16) & 3), kv = (int)(i >> 18);
        float v = 0.f;
        if (n <= 510) { const size_t r = (size_t)kv * 2048 + g * 512 + n; v = H[r * 512 + kv * 256 + c] + H[(r + 1) * 512 + kv * 256 + 128 + c] + bias[kv * 128 + c]; }
        kcvc[i] = (bf16_t)f2bf(v);
    }
}

namespace at {
constexpr int SHM = 16384;
constexpr int L_V = 0, L_K = 3 * SHM, L_WS = 6 * SHM, L_IMP = L_WS + 2048, IMP_LD = 132, L_SEL = L_IMP + 64 * IMP_LD * 4, L_UNI = L_SEL + 1024, L_CNT = L_UNI + 16,
              L_LC = L_CNT + 16, L_LW = L_LC + 64, L_LS = L_LW + 64, L_END = L_LS + 132 * 4;
static_assert(L_END <= MISC_OFF, "attention LDS map");
constexpr float LOG2E = 1.4426950408889634f;
constexpr float CS = 0.088388347648318440f * 1.4426950408889634f;
#define KSWZ(row, colB) ((row) * 256 + ((colB) ^ (((row) & 7) << 4)))
#define SBAR() __builtin_amdgcn_sched_barrier(0)
__device__ __forceinline__ int crow(int r, int hi) { return (r & 3) + 8 * (r >> 2) + 4 * hi; }
__device__ __forceinline__ int v_st(int k, int c) { const int kk = (k & ~0xC) | ((k & 4) << 1) | ((k & 8) >> 1); return ((kk >> 3) * 4 + (c >> 5)) * 512 + ((kk & 7) * 32 + (c & 31)) * 2; }
__device__ __forceinline__ int v_rd_base(int lane) { return ((lane & 3) << 3) | (((lane >> 2) & 3) << 6) | (((lane >> 4) & 1) << 5) | (((lane >> 5) & 1) << 8); }
constexpr int v_rd_off(int d0, int ks, int half) { return d0 * 512 + ks * 4096 + half * 2048; }
template <int OFF> __device__ __forceinline__ s16x4 tr_read(int vb) { s16x4 r; asm volatile("ds_read_b64_tr_b16 %0, %1 offset:%2" : "=&v"(r) : "v"(vb), "i"(OFF) : "memory"); return r; }

__device__ __forceinline__ void qkt(f32x16& p0, f32x16& p1, const LAS char* Ks, const bf16x8 (&qr)[8], int r32, int hi) {
    p0 = f32x16{}; p1 = f32x16{};
#pragma unroll
    for (int d0 = 0; d0 < 8; ++d0) { const int cb = (d0 * 16 + hi * 8) * 2;
        const bf16x8 b0 = *(const LAS bf16x8*)(Ks + KSWZ(r32, cb));
        const bf16x8 b1 = *(const LAS bf16x8*)(Ks + KSWZ(32 + r32, cb));
        p0 = __builtin_amdgcn_mfma_f32_32x32x16_bf16(b0, qr[d0], p0, 0, 0, 0);
        p1 = __builtin_amdgcn_mfma_f32_32x32x16_bf16(b1, qr[d0], p1, 0, 0, 0);
        if (d0 == 3) SBAR(); }
}
template <int D0> __device__ __forceinline__ void pv_one(f32x16& od, int vb, bf16x8 pa0, bf16x8 pa1, bf16x8 pa2, bf16x8 pa3) {
    const s16x4 l0 = tr_read<v_rd_off(D0, 0, 0)>(vb), h0 = tr_read<v_rd_off(D0, 0, 1)>(vb), l1 = tr_read<v_rd_off(D0, 1, 0)>(vb), h1 = tr_read<v_rd_off(D0, 1, 1)>(vb);
    const s16x4 l2 = tr_read<v_rd_off(D0, 2, 0)>(vb), h2 = tr_read<v_rd_off(D0, 2, 1)>(vb), l3 = tr_read<v_rd_off(D0, 3, 0)>(vb), h3 = tr_read<v_rd_off(D0, 3, 1)>(vb);
    asm volatile("s_waitcnt lgkmcnt(0)" ::: "memory"); SBAR();
#define PK(L, H) (bf16x8){L[0], L[1], L[2], L[3], H[0], H[1], H[2], H[3]}
    od = __builtin_amdgcn_mfma_f32_32x32x16_bf16(pa0, PK(l0, h0), od, 0, 0, 0);
    od = __builtin_amdgcn_mfma_f32_32x32x16_bf16(pa1, PK(l1, h1), od, 0, 0, 0);
    od = __builtin_amdgcn_mfma_f32_32x32x16_bf16(pa2, PK(l2, h2), od, 0, 0, 0);
    od = __builtin_amdgcn_mfma_f32_32x32x16_bf16(pa3, PK(l3, h3), od, 0, 0, 0);
#undef PK
}
template <int MODE>
__device__ __forceinline__ void bias_mask(f32x16& p0, f32x16& p1, int b, int t, int hi, float slope2, bool selbit) {
    const float base = (MODE == 0) ? (float)(t - 31 - 1024 * b - 64 * hi) : (float)(t - 64 * b - 4 * hi);
    const float nb = -slope2 * base;
#pragma unroll
    for (int r = 0; r < 16; ++r) {
        const int c0 = (r & 3) + 8 * (r >> 2), c1 = 32 + c0;
        const float k0 = (MODE == 0) ? 16.f * c0 : (float)c0, k1 = (MODE == 0) ? 16.f * c1 : (float)c1;
        const float d0 = base - k0, d1 = base - k1;
        bool v0 = d0 >= 0.f, v1 = d1 >= 0.f;
        if (MODE == 1) { v0 = v0 && selbit; v1 = v1 && selbit; }
        if (MODE == 2) { v0 = v0 && (d0 < 512.f); v1 = v1 && (d1 < 512.f); }
        const float s0 = p0[r] + fmaf(slope2, k0, nb), s1 = p1[r] + fmaf(slope2, k1, nb);
        p0[r] = v0 ? s0 : -__builtin_inff(); p1[r] = v1 ? s1 : -__builtin_inff();
    }
}
__device__ __forceinline__ float swap_max(float v) { auto rr = __builtin_amdgcn_permlane32_swap(__float_as_uint(v), __float_as_uint(v), false, false); return fmaxf(__uint_as_float(rr[0]), __uint_as_float(rr[1])); }
__device__ __forceinline__ float swap_sum(float v) { auto rr = __builtin_amdgcn_permlane32_swap(__float_as_uint(v), __float_as_uint(v), false, false); return __uint_as_float(rr[0]) + __uint_as_float(rr[1]); }

__device__ __forceinline__ void dma_offsets(int ldk, int wid, int lane, int (&offK)[2], int (&offV)[2]) {
#pragma unroll
    for (int i = 0; i < 2; ++i) { const int blk = 2 * wid + i;
        { const int row = 4 * blk + (lane >> 4), cp = lane & 15, sc = cp ^ (row & 7); offK[i] = row * ldk + sc * 8; }
        { const int o = blk * 1024 + lane * 16, sub = o >> 9, kk = ((sub >> 2) << 3) | ((o >> 6) & 7), k = (kk & ~0xC) | ((kk & 4) << 1) | ((kk & 8) >> 1), cc = ((sub & 3) << 2) | ((o >> 4) & 3);
          offV[i] = k * ldk + cc * 8; } }
}
__device__ __forceinline__ void dma_tile(LAS char* dst, const bf16_t* src, size_t rowbase, const int (&off)[2], int wid) {
#pragma unroll
    for (int i = 0; i < 2; ++i) __builtin_amdgcn_global_load_lds((const unsigned*)(src + rowbase + off[i]), (LAS unsigned*)(dst + (2 * wid + i) * 1024), 16, 0, 0);
}
constexpr float RESC_THR = 8.f;

template <int MODE>
__device__ __forceinline__ void flash(LAS char* lds, const bf16_t* Kb, const bf16_t* Vb, int ldk, const LAS int* list, int n, const bf16x8 (&qr)[8],
                                      f32x16 (&o)[4], float& m_reg, float& l_reg, int t, float slope2, const LAS unsigned* selw,
                                      int bA, int bB, int tid, int wid, int lane) {
    const int r32 = lane & 31, hi = lane >> 5;
    LAS char* V_lds = lds + L_V; LAS char* K_lds = lds + L_K;
    LAS float* al_l = (LAS float*)(lds + L_WS) + wid * 64 + 32;
    const int vb0 = (int)(unsigned)(size_t)V_lds + v_rd_base(lane);
#pragma unroll
    for (int d = 0; d < 4; ++d) o[d] = f32x16{};
    m_reg = -1e30f; l_reg = 0.f;
    if (n <= 0) return;
    const float ks = (MODE == 0) ? 16.f : 1.f;
    const int half = wid >> 2;
#define BAR() do { asm volatile("" ::: "memory"); __builtin_amdgcn_s_barrier(); asm volatile("" ::: "memory"); } while (0)
#define DMA(ti, slot) do { const int _b = __builtin_amdgcn_readfirstlane(list[ti]); int offK[2], offV[2]; dma_offsets(ldk, wid, lane, offK, offV); \
        dma_tile(K_lds + (slot) * SHM, Kb, (size_t)_b * 64 * ldk, offK, wid); dma_tile(V_lds + (slot) * SHM, Vb, (size_t)_b * 64 * ldk, offV, wid); } while (0)
#define PV(slot) do { const int _vb = vb0 + (slot) * SHM; pv_one<0>(o[0], _vb, pa0, pa1, pa2, pa3); pv_one<1>(o[1], _vb, pa0, pa1, pa2, pa3); \
        pv_one<2>(o[2], _vb, pa0, pa1, pa2, pa3); pv_one<3>(o[3], _vb, pa0, pa1, pa2, pa3); } while (0)
    DMA(0, 0); if (n > 1) DMA(1, 1); if (n > 2) DMA(2, 2);
    VM_WAIT(); __syncthreads();
    if (half) BAR();
    bf16x8 pa0, pa1, pa2, pa3;
    int buf = 0;
    for (int i = 0; i < n; ++i) {
        const int bcur = __builtin_amdgcn_readfirstlane(list[i]);
        const int pslot = (buf == 0) ? 2 : buf - 1;
        const int nslot = (buf == 2) ? 0 : buf + 1;
        if (half == 0 && i + 1 >= 3 && i + 1 < n) DMA(i + 1, nslot);
        if (i > 0) PV(pslot);
        f32x16 p0, p1;
        qkt(p0, p1, K_lds + buf * SHM, qr, r32, hi);
        if (half == 1) VM_WAIT();
        BAR();
        if (half == 1 && i + 2 >= 3 && i + 2 < n) DMA(i + 2, pslot);
        const int dist0 = (MODE == 0) ? (t - 31 - 1024 * bcur - 64 * hi) : (t - 64 * bcur - 4 * hi);
        float nbl = -slope2 * (float)dist0;
        if (MODE == 1) { const unsigned mw = selw[bcur >> 5]; if (!((mw >> (bcur & 31)) & 1u)) nbl = -__builtin_inff(); }
#pragma unroll
        for (int r = 0; r < 16; ++r) { const float c0 = ks * (float)((r & 3) + 8 * (r >> 2)), c1 = c0 + 32.f * ks; p0[r] = fmaf(slope2, c0, p0[r]); p1[r] = fmaf(slope2, c1, p1[r]); }
        if (bcur >= bA || bcur == bB) {
            const float base = (float)dist0;
#pragma unroll
            for (int r = 0; r < 16; ++r) { const float c0 = ks * (float)((r & 3) + 8 * (r >> 2)), c1 = c0 + 32.f * ks; const float d0 = base - c0, d1 = base - c1;
                bool v0 = d0 >= 0.f, v1 = d1 >= 0.f;
                if (MODE == 2) { v0 = v0 && (d0 < 512.f); v1 = v1 && (d1 < 512.f); }
                p0[r] = v0 ? p0[r] : -__builtin_inff(); p1[r] = v1 ? p1[r] : -__builtin_inff(); }
        }
        float pmax = p0[0], pmax1 = p1[0];
#pragma unroll
        for (int r = 1; r < 16; ++r) { pmax = fmaxf(pmax, p0[r]); pmax1 = fmaxf(pmax1, p1[r]); }
        pmax = swap_max(fmaxf(pmax, pmax1) + nbl);
        if (!__all(pmax - m_reg <= RESC_THR)) {
            const float mn = fmaxf(m_reg, pmax), alpha = __builtin_amdgcn_exp2f(m_reg - mn);
            m_reg = mn; l_reg *= alpha;
            if (hi == 0) al_l[r32] = alpha; LDS_WAIT();
#pragma unroll
            for (int r = 0; r < 16; ++r) { const float a = al_l[crow(r, hi)];
#pragma unroll
                for (int d = 0; d < 4; ++d) o[d][r] *= a; }
        }
        const float nm = nbl - m_reg;
        float ps = 0.f;
#pragma unroll
        for (int r = 0; r < 16; ++r) { p0[r] = __builtin_amdgcn_exp2f(p0[r] + nm); ps += p0[r]; }
#pragma unroll
        for (int r = 0; r < 16; ++r) { p1[r] = __builtin_amdgcn_exp2f(p1[r] + nm); ps += p1[r]; }
        l_reg += swap_sum(ps);
#define PK4(P, BASE, OUT) do { unsigned a0 = cvtpk(P[BASE + 0], P[BASE + 1]), a1 = cvtpk(P[BASE + 2], P[BASE + 3]); \
        unsigned b0 = cvtpk(P[BASE + 4], P[BASE + 5]), b1 = cvtpk(P[BASE + 6], P[BASE + 7]); \
        auto r0 = __builtin_amdgcn_permlane32_swap(a0, b0, false, false); auto r1 = __builtin_amdgcn_permlane32_swap(a1, b1, false, false); \
        u32x4 w = {r0[0], r1[0], r0[1], r1[1]}; OUT = *reinterpret_cast<bf16x8*>(&w); } while (0)
        PK4(p0, 0, pa0); PK4(p0, 8, pa1); PK4(p1, 0, pa2); PK4(p1, 8, pa3);
#undef PK4
        if (half == 0) VM_WAIT();
        BAR();
        buf = nslot;
    }
    { const int pslot = (buf == 0) ? 2 : buf - 1; PV(pslot); }
    BAR();
    if (half == 0) BAR();
#undef PV
#undef DMA
#undef BAR
}

template <int BR>
__device__ __forceinline__ void accum_branch(float* acc_g, bf16_t* out_g, const f32x16 (&o)[4], float fac, LAS float* li_l, int r32, int hi, unsigned* rmax = nullptr) {
    if (hi == 0) li_l[r32] = fac;
    LDS_WAIT();
    float ld[2][4][4];
    if (BR > 0) {
#pragma unroll
        for (int rq = 0; rq < 4; ++rq)
#pragma unroll
            for (int d = 0; d < 4; ++d) ld[0][rq][d] = (acc_g + (size_t)(4 * hi) * 2048 + r32)[rq * 128 + 32 * d]; }
#pragma unroll
    for (int rr = 0; rr < 4; ++rr) {
        float* ab = acc_g + (size_t)(rr + 4 * hi) * 2048 + r32; bf16_t* ob = out_g + (size_t)(rr + 4 * hi) * 2048 + r32;
        if (BR > 0 && rr < 3) {
#pragma unroll
            for (int rq = 0; rq < 4; ++rq)
#pragma unroll
                for (int d = 0; d < 4; ++d) ld[(rr + 1) & 1][rq][d] = (ab + 2048)[rq * 128 + 32 * d]; }
        __builtin_amdgcn_sched_barrier(0);
        float v[4][4];
#pragma unroll
        for (int rq = 0; rq < 4; ++rq) { const float f = li_l[rr + 8 * rq + 4 * hi];
#pragma unroll
            for (int d = 0; d < 4; ++d) { v[rq][d] = o[d][4 * rq + rr] * f; if (BR > 0) v[rq][d] += ld[rr & 1][rq][d]; } }
        float amx = 0.f;
#pragma unroll
        for (int rq = 0; rq < 4; ++rq)
#pragma unroll
            for (int d = 0; d < 4; ++d) { if (BR < 2) ab[rq * 128 + 32 * d] = v[rq][d]; else { const unsigned hb = f2bf(v[rq][d]); ob[rq * 128 + 32 * d] = (bf16_t)hb; amx = fmaxf(amx, fabsf(bflo(hb))); } }
        if (BR == 2) {
            amx = fmaxf(amx, __shfl_xor(amx, 1)); amx = fmaxf(amx, __shfl_xor(amx, 2)); amx = fmaxf(amx, __shfl_xor(amx, 4)); amx = fmaxf(amx, __shfl_xor(amx, 8)); amx = fmaxf(amx, __shfl_xor(amx, 16));
            if (r32 == 0) atomicMax(rmax + rr + 4 * hi, __float_as_uint(amx)); }
        __builtin_amdgcn_sched_barrier(0);
    }
    LDS_WAIT();
}

__device__ __forceinline__ void attn_unit(const Frame& F, unsigned char* ws, int g, int qt) {
    LAS char* lds = (LAS char*)F.lds;
    const int tid = F.tid, wid = F.wave, lane = F.lane, r32 = lane & 31, hi = lane >> 5;
    const bf16_t* Z = (const bf16_t*)(ws + WS_R1);
    LAS float* imp = (LAS float*)(lds + L_IMP); LAS unsigned* sel = (LAS unsigned*)(lds + L_SEL); LAS unsigned* uni = (LAS unsigned*)(lds + L_UNI);
    LAS int* cnt = (LAS int*)(lds + L_CNT); LAS int* LC = (LAS int*)(lds + L_LC); LAS int* LW = (LAS int*)(lds + L_LW); LAS int* LS = (LAS int*)(lds + L_LS);
    LAS float* li_l = (LAS float*)(lds + L_WS) + wid * 64;
    const int t0 = 64 * qt, cur = qt;
    __syncthreads();
    for (int i = tid; i < 64 * IMP_LD; i += NTHREADS) imp[i] = 0.f;
    if (tid < 4) uni[tid] = 0u;
    if (tid == 0) { const int nc = ((4 * qt + 2) >> 6) + 1; for (int i = 0; i < nc; ++i) LC[i] = nc - 1 - i; cnt[0] = nc;
        const int b0 = qt > 8 ? qt - 8 : 0, nw = qt - b0 + 1; for (int i = 0; i < nw; ++i) LW[i] = qt - i; cnt[2] = nw; }
    __syncthreads();
    const int hh = r32 >> 3, jt = r32 & 7, tl = 8 * wid + jt, t = t0 + tl, head = g * 4 + hh;
    bf16x8 qr[8];
    { const bf16_t* Qrow = Z + (size_t)t * ZW + ZC_Q + head * 128 + hi * 8;
#pragma unroll
      for (int d0 = 0; d0 < 8; ++d0) qr[d0] = *(const bf16x8*)(Qrow + d0 * 16); }
    const float slope2 = __builtin_amdgcn_exp2f(-0.5f * (float)(head + 1)) * LOG2E;
    const bf16_t* gz = Z + (size_t)t * ZW + ZC_G + head * 3;
    const float g_cmp = sigmoidf_(bf2f(gz[0])), g_slc = sigmoidf_(bf2f(gz[1])), g_win = sigmoidf_(bf2f(gz[2]));
    const int nc = cnt[0], nw = cnt[2];
    f32x16 o[4]; float m_reg, l_reg;
    float* acc_g = (float*)(ws + WS_B) + (size_t)(t0 + 8 * wid) * 2048 + (size_t)g * 512;
    bf16_t* out_g = (bf16_t*)(ws + WS_NSA) + (size_t)(t0 + 8 * wid) * 2048 + (size_t)g * 512;
    const bf16_t* kc = (const bf16_t*)(ws + WS_KCVC) + (size_t)g * 512 * 128; const bf16_t* vc = kc + (size_t)4 * 512 * 128;
    flash<0>(lds, kc, vc, 128, LC, nc, qr, o, m_reg, l_reg, t, slope2, sel, (4 * qt - 1) >> 6, -1, tid, wid, lane);
    const float inv_lc = l_reg > 0.f ? 1.f / l_reg : 0.f;
    accum_branch<0>(acc_g, out_g, o, g_cmp * inv_lc, li_l, r32, hi);
    { const float m_c = m_reg;
      LAS char* K_lds = lds + L_K;
      __syncthreads();
      { int offK[2], offV[2]; dma_offsets(128, wid, lane, offK, offV); dma_tile(K_lds, kc, 0, offK, wid); }
      VM_WAIT(); __syncthreads();
#pragma unroll 1
      for (int i = 0; i < nc; ++i) {
        if (i + 1 < nc) { int offK[2], offV[2]; dma_offsets(128, wid, lane, offK, offV); dma_tile(K_lds + ((i + 1) & 1) * SHM, kc, (size_t)(i + 1) * 64 * 128, offK, wid); }
        f32x16 p0, p1;
        qkt(p0, p1, K_lds + (i & 1) * SHM, qr, r32, hi);
        bias_mask<0>(p0, p1, i, t, hi, slope2, true);
#pragma unroll
        for (int r = 0; r < 16; ++r) { float v0 = __builtin_amdgcn_exp2f(p0[r] - m_c) * inv_lc, v1 = __builtin_amdgcn_exp2f(p1[r] - m_c) * inv_lc;
            v0 += __int_as_float(__builtin_amdgcn_update_dpp(0, __float_as_int(v0), 0x128, 0xf, 0xf, false)); v1 += __int_as_float(__builtin_amdgcn_update_dpp(0, __float_as_int(v1), 0x128, 0xf, 0xf, false));
            { auto q0 = __builtin_amdgcn_permlane16_swap(__float_as_uint(v0), __float_as_uint(v0), false, false); v0 = __uint_as_float(q0[0]) + __uint_as_float(q0[1]); }
            { auto q1 = __builtin_amdgcn_permlane16_swap(__float_as_uint(v1), __float_as_uint(v1), false, false); v1 = __uint_as_float(q1[0]) + __uint_as_float(q1[1]); }
            p0[r] = v0; p1[r] = v1; }
        if (r32 < 8) {
            LAS float* row = imp + tl * IMP_LD + 16 * i + hi;
#pragma unroll
            for (int a4 = 0; a4 < 4; ++a4) {
                const float s0 = (p0[4 * a4] + p0[4 * a4 + 1]) + (p0[4 * a4 + 2] + p0[4 * a4 + 3]), s1 = (p1[4 * a4] + p1[4 * a4 + 1]) + (p1[4 * a4 + 2] + p1[4 * a4 + 3]);
                atomicAdd((float*)(row + 2 * a4), s0); atomicAdd((float*)(row + 2 * a4 + 8), s1);
                atomicAdd((float*)(row + 2 * a4 + 1), p0[4 * a4 + 3]); atomicAdd((float*)(row + 2 * a4 + 9), p1[4 * a4 + 3]); }
        }
        VM_WAIT();
        __syncthreads();
      }
    }
    LDS_WAIT();
    {
        unsigned key0[8], key1[8], w0[8], w1[8], w2[8], w3[8];
#pragma unroll
        for (int j = 0; j < 8; ++j) { const LAS float* row = imp + (8 * wid + j) * IMP_LD;
            { const int kk = lane; const unsigned bits = __float_as_uint(row[kk]);
              key0[j] = (kk > cur) ? 0u : (kk == 0 || kk == cur || kk == cur - 1) ? (0xFFFFFF80u | (unsigned)(127 - kk)) : ((((bits >> 7) + 1u) << 7) | (unsigned)(127 - kk)); }
            { const int kk = lane + 64; const unsigned bits = __float_as_uint(row[kk]);
              key1[j] = (kk > cur) ? 0u : (kk == cur || kk == cur - 1) ? (0xFFFFFF80u | (unsigned)(127 - kk)) : ((((bits >> 7) + 1u) << 7) | (unsigned)(127 - kk)); }
            w0[j] = 0u; w1[j] = 0u; w2[j] = 0u; w3[j] = 0u; }
        for (int it = 0; it < 16; ++it) {
#pragma unroll
            for (int j = 0; j < 8; ++j) {
                const unsigned M = __reduce_max_sync(~0ull, key0[j] > key1[j] ? key0[j] : key1[j]);
                const unsigned kk = 127u - (M & 127u), bit = (M != 0u) ? (1u << (kk & 31u)) : 0u, wq = kk >> 5;
                w0[j] |= (wq == 0u) ? bit : 0u; w1[j] |= (wq == 1u) ? bit : 0u; w2[j] |= (wq == 2u) ? bit : 0u; w3[j] |= (wq == 3u) ? bit : 0u;
                key0[j] = (key0[j] == M) ? 0u : key0[j]; key1[j] = (key1[j] == M) ? 0u : key1[j];
            }
        }
        if (lane == 0) {
#pragma unroll
            for (int j = 0; j < 8; ++j) { const int tj = 8 * wid + j; sel[tj * 4 + 0] = w0[j]; sel[tj * 4 + 1] = w1[j]; sel[tj * 4 + 2] = w2[j]; sel[tj * 4 + 3] = w3[j];
                atomicOr((unsigned*)&uni[0], w0[j]); atomicOr((unsigned*)&uni[1], w1[j]); atomicOr((unsigned*)&uni[2], w2[j]); atomicOr((unsigned*)&uni[3], w3[j]); }
        }
    }
    __syncthreads();
    if (tid < 128) {
        const unsigned u0 = uni[0], u1 = uni[1], u2 = uni[2], u3 = uni[3]; const int b = tid, wq = b >> 5, sh = b & 31;
        const unsigned uw = (wq == 0) ? u0 : (wq == 1) ? u1 : (wq == 2) ? u2 : u3;
        if ((uw >> sh) & 1u) { int rank = (sh == 31) ? 0 : __builtin_popcount(uw >> (sh + 1));
            if (wq < 1) rank += __builtin_popcount(u1); if (wq < 2) rank += __builtin_popcount(u2); if (wq < 3) rank += __builtin_popcount(u3);
            LS[rank] = b; }
        if (tid == 0) cnt[1] = __builtin_popcount(u0) + __builtin_popcount(u1) + __builtin_popcount(u2) + __builtin_popcount(u3);
    }
    __syncthreads();
    const int ns = cnt[1];
    flash<1>(lds, Z + ZC_KV + (2 * 4 + g) * 128, Z + ZC_KV + (3 * 4 + g) * 128, ZW, LS, ns, qr, o, m_reg, l_reg, t, slope2, sel + tl * 4, cur, -1, tid, wid, lane);
    accum_branch<1>(acc_g, out_g, o, l_reg > 0.f ? g_slc / l_reg : 0.f, li_l, r32, hi);
    flash<2>(lds, Z + ZC_KV + (4 * 4 + g) * 128, Z + ZC_KV + (5 * 4 + g) * 128, ZW, LW, nw, qr, o, m_reg, l_reg, t, slope2, sel, cur, cur - 8, tid, wid, lane);
    accum_branch<2>(acc_g, out_g, o, l_reg > 0.f ? g_win / l_reg : 0.f, li_l, r32, hi, (unsigned*)(ws + WS_CTL) + CW_ROWMAX_N + t0 + 8 * wid);
}
#undef KSWZ
#undef SBAR
}

__device__ __forceinline__ void phase_attention(const Frame& F, const Args& a) {
    for (int L = F.bid; L < 512; L += F.G) { const int g = L & 3, qt = (L < 256) ? 127 - (L >> 2) : ((L - 256) >> 2); at::attn_unit(F, a.ws, g, qt); }
}


namespace pk {
constexpr int SC_LD = 132;
__device__ __forceinline__ int crow(int r, int hi) { return (r & 3) + 8 * (r >> 2) + 4 * hi; }
__device__ __forceinline__ void sort16_desc(unsigned (&a)[16]) {
#pragma unroll
    for (int k = 2; k <= 16; k <<= 1)
#pragma unroll
        for (int j = k >> 1; j > 0; j >>= 1)
#pragma unroll
            for (int i = 0; i < 16; ++i) { const int l = i ^ j; if (l > i) { const unsigned mx = a[i] > a[l] ? a[i] : a[l], mn = a[i] > a[l] ? a[l] : a[i]; const bool desc = ((i & k) == 0);
                a[i] = desc ? mx : mn; a[l] = desc ? mn : mx; } }
}
__device__ __forceinline__ void merge16_desc(unsigned (&a)[16], unsigned (&b)[16]) {
#pragma unroll
    for (int i = 0; i < 16; ++i) a[i] = a[i] > b[15 - i] ? a[i] : b[15 - i];
#pragma unroll
    for (int j = 8; j > 0; j >>= 1)
#pragma unroll
        for (int i = 0; i < 16; ++i) { const int l = i ^ j; if (l > i) { const unsigned mx = a[i] > a[l] ? a[i] : a[l], mn = a[i] > a[l] ? a[l] : a[i]; a[i] = mx; a[l] = mn; } }
}
__device__ __forceinline__ void score_tile(const Frame& F, unsigned char* ws, int tile) {
    LAS float* sc = (LAS float*)F.lds;
    const int tid = F.tid, wid = F.wave, lane = F.lane, r32 = lane & 31, hi = lane >> 5;
    const bf16_t* qp = (const bf16_t*)(ws + WS_B); const bf16_t* keys = (const bf16_t*)(ws + WS_SMALL + 4096);
    const int t0 = tile * 16;
    {
        const int side = wid >> 2, rho = 32 * (wid & 3) + r32, tl = rho >> 3, head = rho & 7;
        const bf16_t* qrow = qp + (size_t)(t0 + tl) * 2048 + head * 256 + side * 128 + hi * 8;
        bf16x8 qf[8];
#pragma unroll
        for (int d0 = 0; d0 < 8; ++d0) qf[d0] = *(const bf16x8*)(qrow + d0 * 16);
        const bf16_t* kb_ = keys + (size_t)side * 128 * 128 + (size_t)r32 * 128 + hi * 8;
        f32x16 acc[4]; bf16x8 ka[2][8];
#pragma unroll
        for (int d0 = 0; d0 < 8; ++d0) ka[0][d0] = *(const bf16x8*)(kb_ + d0 * 16);
#pragma unroll
        for (int kb = 0; kb < 4; ++kb) { acc[kb] = f32x16{};
            if (kb < 3) {
#pragma unroll
                for (int d0 = 0; d0 < 8; ++d0) ka[(kb + 1) & 1][d0] = *(const bf16x8*)(kb_ + (size_t)(kb + 1) * 32 * 128 + d0 * 16); }
            __builtin_amdgcn_sched_barrier(0);
#pragma unroll
            for (int d0 = 0; d0 < 8; ++d0) acc[kb] = __builtin_amdgcn_mfma_f32_32x32x16_bf16(ka[kb & 1][d0], qf[d0], acc[kb], 0, 0, 0);
            __builtin_amdgcn_sched_barrier(0); }
        LAS float* row = sc + (side * 128 + rho) * SC_LD;
#pragma unroll
        for (int kb = 0; kb < 4; ++kb)
#pragma unroll
            for (int a4 = 0; a4 < 4; ++a4) *(LAS f32x4*)(row + kb * 32 + 8 * a4 + 4 * hi) = (f32x4){acc[kb][4 * a4], acc[kb][4 * a4 + 1], acc[kb][4 * a4 + 2], acc[kb][4 * a4 + 3]};
    }
    __syncthreads();
    if (tid < 256) {
        LAS float* row = sc + tid * SC_LD;
        unsigned best[16];
#pragma unroll 1
        for (int g = 0; g < 8; ++g) {
            unsigned a[16];
#pragma unroll
            for (int q = 0; q < 4; ++q) { const f32x4 v = *(const LAS f32x4*)(row + 16 * g + 4 * q);
#pragma unroll
                for (int e = 0; e < 4; ++e) { const unsigned u = __float_as_uint(v[e]); const unsigned ord = u ^ ((unsigned)((int)u >> 31) | 0x80000000u);
                    a[4 * q + e] = (ord & 0xFFFFFF80u) | (unsigned)(127 - (16 * g + 4 * q + e)); } }
            sort16_desc(a);
            if (g == 0) {
#pragma unroll
                for (int i = 0; i < 16; ++i) best[i] = a[i];
            } else merge16_desc(best, a);
        }
        float bv[16];
#pragma unroll
        for (int i = 0; i < 16; ++i) { const int idx = 127 - (int)(best[i] & 127u); bv[i] = row[idx]; best[i] = (unsigned)idx; }
#pragma unroll
        for (int i = 0; i < 16; ++i) { row[i] = bv[i]; row[16 + i] = __int_as_float((int)best[i]); }
    }
    __syncthreads();
    if (tid < 128) {
        const LAS float* r1 = sc + tid * SC_LD; const LAS float* r2 = sc + (128 + tid) * SC_LD;
        float v1[16], v2[16];
#pragma unroll
        for (int i = 0; i < 16; ++i) { v1[i] = r1[i]; v2[i] = r2[i]; }
        unsigned c[64];
#pragma unroll
        for (int i = 0; i < 64; ++i) c[i] = 0u;
        {
            int n = 0;
#pragma unroll
            for (int a = 0; a < 16; ++a)
#pragma unroll
                for (int b = 0; b < 16; ++b) if ((a + 1) * (b + 1) <= 16) { const unsigned u = __float_as_uint(v1[a] + v2[b]); const unsigned ord = u ^ ((unsigned)((int)u >> 31) | 0x80000000u);
                    c[n] = (ord & 0xFFFFFF00u) | (unsigned)(255 - (a * 16 + b)); ++n; }
        }
        unsigned best[16], g1[16], g2[16], g3[16];
#pragma unroll
        for (int i = 0; i < 16; ++i) { best[i] = c[i]; g1[i] = c[16 + i]; g2[i] = c[32 + i]; g3[i] = c[48 + i]; }
        sort16_desc(best); sort16_desc(g1); sort16_desc(g2); sort16_desc(g3);
        merge16_desc(best, g1); merge16_desc(g2, g3); merge16_desc(best, g2);
        float val[16]; int ex[16];
#pragma unroll
        for (int i = 0; i < 16; ++i) { const int fl = 255 - (int)(best[i] & 255u), a = fl >> 4, b = fl & 15;
            val[i] = r1[a] + r2[b]; ex[i] = __float_as_int(r1[16 + a]) * 128 + __float_as_int(r2[16 + b]); }
        float smax = val[0];
#pragma unroll
        for (int i = 1; i < 16; ++i) smax = fmaxf(smax, val[i]);
        float ssum = 0.f, gsm[16];
#pragma unroll
        for (int i = 0; i < 16; ++i) { gsm[i] = __builtin_amdgcn_exp2f((val[i] - smax) * 1.4426950408889634f); ssum += gsm[i]; }
        const float inv = 1.f / ssum;
        const int tl = tid >> 3, head = tid & 7;
        int* pe = (int*)(ws + WS_PE) + (size_t)(t0 + tl) * 128 + head * 16; float* pg = (float*)(ws + WS_PG) + (size_t)(t0 + tl) * 128 + head * 16;
#pragma unroll
        for (int q = 0; q < 4; ++q) { *(int4*)(pe + 4 * q) = make_int4(ex[4 * q], ex[4 * q + 1], ex[4 * q + 2], ex[4 * q + 3]);
            *(f32x4*)(pg + 4 * q) = (f32x4){gsm[4 * q] * inv, gsm[4 * q + 1] * inv, gsm[4 * q + 2] * inv, gsm[4 * q + 3] * inv}; }
    }
    __syncthreads();
}
}
__device__ __forceinline__ void phase_peer_score(const Frame& F, const Args& a) { for (int tile = F.bid; tile < T / 16; tile += F.G) pk::score_tile(F, a.ws, tile); }

__device__ __forceinline__ float gelu_tanh(float a) {
    const float y = 0.7978845608028654f * (a + 0.044715f * a * a * a);
    const float th = 1.f - 2.f * __builtin_amdgcn_rcpf(1.f + __builtin_amdgcn_exp2f(2.8853900817779268f * y));
    return 0.5f * a * (1.f + th);
}
constexpr size_t PT_V8 = (size_t)64 * MiB, PT_US = (size_t)128 * MiB, PT_VS = PT_US + 65536, PT_SLICE = (size_t)16384 * 256;
__device__ __forceinline__ float wave_max(float v) {
#pragma unroll
    for (int o = 1; o < 64; o <<= 1) v = fmaxf(v, __shfl_xor(v, o));
    return v;
}
__device__ __forceinline__ void cvt_row_fp8(const float* src, unsigned char* tab, int e, float* inv_out, int lane) {
    const f32x4* sp = (const f32x4*)src + lane; f32x4 v[16]; float amax = 0.f;
#pragma unroll
    for (int j = 0; j < 16; ++j) { v[j] = sp[64 * j]; amax = fmaxf(fmaxf(amax, fmaxf(fabsf(v[j].x), fabsf(v[j].y))), fmaxf(fabsf(v[j].z), fabsf(v[j].w))); }
    amax = wave_max(amax);
    const int ef = (int)((__float_as_uint(amax) >> 23) & 0xffu);
    const int ex = (ef >= 64 && ef < 250) ? ef - 126 : 8;
    const float scale = __uint_as_float((unsigned)(127 + 8 - ex) << 23), inv = __uint_as_float((unsigned)(127 - 8 + ex) << 23);
#pragma unroll
    for (int j = 0; j < 16; ++j) { int pk = __builtin_amdgcn_cvt_pk_fp8_f32(v[j].x * scale, v[j].y * scale, 0, false); pk = __builtin_amdgcn_cvt_pk_fp8_f32(v[j].z * scale, v[j].w * scale, pk, true);
        ((unsigned*)(tab + (size_t)j * PT_SLICE + (size_t)e * 256))[lane] = (unsigned)pk; }
    if (lane == 0) *inv_out = inv;
}
__device__ __forceinline__ void cvt_row_i8(const float* src, unsigned char* tab, int e, float* inv_out, int lane) {
    const f32x4* sp = (const f32x4*)src + lane; f32x4 v[16]; float amax = 0.f;
#pragma unroll
    for (int j = 0; j < 16; ++j) { v[j] = sp[64 * j]; amax = fmaxf(fmaxf(amax, fmaxf(fabsf(v[j].x), fabsf(v[j].y))), fmaxf(fabsf(v[j].z), fabsf(v[j].w))); }
    amax = wave_max(amax);
    const float scale = amax > 0.f ? 127.f / amax : 0.f;
#pragma unroll
    for (int j = 0; j < 16; ++j) ((unsigned*)(tab + (size_t)j * PT_SLICE + (size_t)e * 256))[lane] = pack_i8x4(v[j].x * scale, v[j].y * scale, v[j].z * scale, v[j].w * scale);
    if (lane == 0) *inv_out = amax * (1.f / 127.f);
}
__device__ __forceinline__ void pt_load(const float* tu, const float* tv, f32x4* v, int r, int lane) {
    const f32x4* sp = (const f32x4*)(((r >> 14) ? tv : tu) + (size_t)(r & 16383) * D) + lane;
#pragma unroll
    for (int j = 0; j < 16; ++j) v[j] = sp[64 * j];
}
__device__ __forceinline__ void pt_proc(unsigned char* PT, const f32x4* v, int r, int lane) {
    const int tb = r >> 14, e = r & 16383; unsigned char* tab = PT + (tb ? PT_V8 : 0); float amax = 0.f;
#pragma unroll
    for (int j = 0; j < 16; ++j) amax = fmaxf(fmaxf(amax, fmaxf(fabsf(v[j].x), fabsf(v[j].y))), fmaxf(fabsf(v[j].z), fabsf(v[j].w)));
    amax = wave_max(amax); const float scale = amax > 0.f ? 127.f / amax : 0.f;
#pragma unroll
    for (int j = 0; j < 16; ++j) ((unsigned*)(tab + (size_t)j * PT_SLICE + (size_t)e * 256))[lane] = pack_i8x4(v[j].x * scale, v[j].y * scale, v[j].z * scale, v[j].w * scale);
    if (lane == 0) ((float*)(PT + (tb ? PT_VS : PT_US)))[e] = amax * (1.f / 127.f);
}
__device__ __forceinline__ void phase_peer_tables(const Frame& F, const Args& a, int r_lo, int r_hi, int gw, int NGW) {
    unsigned char* PT = a.ws + WS_PT; const int lane = F.lane;
    int r = r_lo + gw; if (r >= r_hi) return;
    f32x4 vA[16], vB[16];
    pt_load(a.in[17], a.in[18], vA, r, lane);
    for (;;) {
        const int r1 = r + NGW; const bool h1 = r1 < r_hi;
        if (h1) pt_load(a.in[17], a.in[18], vB, r1, lane);
        pt_proc(PT, vA, r, lane);
        if (!h1) break;
        const int r2 = r1 + NGW; const bool h2 = r2 < r_hi;
        if (h2) pt_load(a.in[17], a.in[18], vA, r2, lane);
        pt_proc(PT, vB, r1, lane);
        if (!h2) break;
        r = r2;
    }
}
struct TableSide { static constexpr bool ON = true; const Frame* F; const Args* a; int slot, on;
    __device__ void after(int ui) const { if (on && ui == slot) { f32x4 sv[16];
        for (int k = 0; k < 8; ++k) { const int r = F->vid * 64 + 8 * k + F->wave; pt_load(a->in[17], a->in[18], sv, r, F->lane); pt_proc(a->ws + WS_PT, sv, r, F->lane); } } } };
__device__ __forceinline__ int idot16(u32x4 w, u32x4 h) {
    int r = __builtin_amdgcn_sdot4((int)w.x, (int)h.x, 0, false); r = __builtin_amdgcn_sdot4((int)w.y, (int)h.y, r, false);
    r = __builtin_amdgcn_sdot4((int)w.z, (int)h.z, r, false); return __builtin_amdgcn_sdot4((int)w.w, (int)h.w, r, false);
}
__device__ __forceinline__ f32x2 dot16(u32x4 w, const f32x2* h, f32x2 s) {
    s = __builtin_elementwise_fma(__builtin_amdgcn_cvt_pk_f32_fp8((int)w.x, false), h[0], s); s = __builtin_elementwise_fma(__builtin_amdgcn_cvt_pk_f32_fp8((int)w.x, true), h[1], s);
    s = __builtin_elementwise_fma(__builtin_amdgcn_cvt_pk_f32_fp8((int)w.y, false), h[2], s); s = __builtin_elementwise_fma(__builtin_amdgcn_cvt_pk_f32_fp8((int)w.y, true), h[3], s);
    s = __builtin_elementwise_fma(__builtin_amdgcn_cvt_pk_f32_fp8((int)w.z, false), h[4], s); s = __builtin_elementwise_fma(__builtin_amdgcn_cvt_pk_f32_fp8((int)w.z, true), h[5], s);
    s = __builtin_elementwise_fma(__builtin_amdgcn_cvt_pk_f32_fp8((int)w.w, false), h[6], s); s = __builtin_elementwise_fma(__builtin_amdgcn_cvt_pk_f32_fp8((int)w.w, true), h[7], s);
    return s;
}
__device__ __forceinline__ void axpy16(u32x4 w, float co, f32x2* acc) {
    const f32x2 c2 = {co, co};
    acc[0] = __builtin_elementwise_fma(c2, __builtin_amdgcn_cvt_pk_f32_fp8((int)w.x, false), acc[0]); acc[1] = __builtin_elementwise_fma(c2, __builtin_amdgcn_cvt_pk_f32_fp8((int)w.x, true), acc[1]);
    acc[2] = __builtin_elementwise_fma(c2, __builtin_amdgcn_cvt_pk_f32_fp8((int)w.y, false), acc[2]); acc[3] = __builtin_elementwise_fma(c2, __builtin_amdgcn_cvt_pk_f32_fp8((int)w.y, true), acc[3]);
    acc[4] = __builtin_elementwise_fma(c2, __builtin_amdgcn_cvt_pk_f32_fp8((int)w.z, false), acc[4]); acc[5] = __builtin_elementwise_fma(c2, __builtin_amdgcn_cvt_pk_f32_fp8((int)w.z, true), acc[5]);
    acc[6] = __builtin_elementwise_fma(c2, __builtin_amdgcn_cvt_pk_f32_fp8((int)w.w, false), acc[6]); acc[7] = __builtin_elementwise_fma(c2, __builtin_amdgcn_cvt_pk_f32_fp8((int)w.w, true), acc[7]);
}
__device__ __forceinline__ void phase_peer_a(const Frame& F, const Args& a, const int emask, float* PA) {
    unsigned char* ws = a.ws;
    const unsigned char* U8 = ws + WS_PT; const unsigned char* H2Q = ws + WS_NSA; const int* PE = (const int*)(ws + WS_PE);
    const int lane = F.lane, rg = lane >> 4, li = lane & 15, xs = F.vid & 7, rank = F.vid >> 3, nrank = (F.G - xs + 7) >> 3, step = nrank * 8;
    LAS int* lpe = (LAS int*)(F.lds + F.wave * 2048);
    const bool b3 = li & 8, b2 = li & 4, b1 = li & 2, b0 = li & 1;
#define PA_LOADS(dst, buf, half) do { _Pragma("unroll") for (int j = 0; j < 16; ++j) { const unsigned e = (unsigned)lpe[(buf) * 128 + 4 * ((half) * 16 + j) + rg]; dst[j] = *(const u32x4*)(Us + (size_t)(e * 256u + lo16)); } } while (0)
    const unsigned lo16 = (unsigned)li * 16u;
    for (int pass = 0; pass < 2; ++pass) { const int sl = pass * 8 + xs; const unsigned char* Us = U8 + (size_t)sl * PT_SLICE;
        int tok = rank * 8 + F.wave;
        if (tok >= T) continue;
        u32x4 hq0, hn0 = {0, 0, 0, 0}; int pn0 = 0, pn1 = 0;
        { hq0 = *(const u32x4*)(H2Q + (size_t)tok * D + sl * 256 + li * 16);
          lpe[lane] = PE[(size_t)tok * 128 + lane] & emask; lpe[64 + lane] = PE[(size_t)tok * 128 + 64 + lane] & emask; lpe[128 + lane] = 0; lpe[192 + lane] = 0;
          if (tok + step < T) { pn0 = PE[(size_t)(tok + step) * 128 + lane]; pn1 = PE[(size_t)(tok + step) * 128 + 64 + lane]; } }
        LDS_WAIT();
        u32x4 wA[16], wB[16];
        PA_LOADS(wA, 0, 0);
        int cur = 0;
        for (; tok < T; tok += step) {
            const int tn = tok + step; const bool has_next = tn < T;
            if (has_next) { lpe[(cur ^ 1) * 128 + lane] = pn0 & emask; lpe[(cur ^ 1) * 128 + 64 + lane] = pn1 & emask;
                hn0 = *(const u32x4*)(H2Q + (size_t)tn * D + sl * 256 + li * 16);
                if (tn + step < T) { pn0 = PE[(size_t)(tn + step) * 128 + lane]; pn1 = PE[(size_t)(tn + step) * 128 + 64 + lane]; } }
            float* pa = PA + ((size_t)xs * T + tok) * 128 + rg;
            float o0 = 0.f, o1 = 0.f;
            if (pass) { o0 = pa[4 * (2 * li)]; o1 = pa[4 * (2 * li + 1)]; }
            PA_LOADS(wB, cur, 1);
            int v[32];
#pragma unroll
            for (int j = 0; j < 16; ++j) v[j] = idot16(wA[j], hq0);
            LDS_WAIT();
            PA_LOADS(wA, cur ^ 1, 0);
#pragma unroll
            for (int j = 0; j < 16; ++j) v[16 + j] = idot16(wB[j], hq0);
#define PA_STEP(N, B, CTRL) _Pragma("unroll") for (int i = 0; i < N; ++i) { const int snd = B ? v[i] : v[N + i], kp = B ? v[N + i] : v[i]; v[i] = kp + __builtin_amdgcn_update_dpp(0, snd, CTRL, 0xf, 0xf, false); }
            PA_STEP(16, b3, 0x128) PA_STEP(8, b2, 0x141) PA_STEP(4, b1, 0x4E) PA_STEP(2, b0, 0xB1)
#undef PA_STEP
            pa[4 * (2 * li)] = (float)v[0] + o0; pa[4 * (2 * li + 1)] = (float)v[1] + o1;
            hq0 = hn0; cur ^= 1;
        }
        LDS_WAIT();
    }
#undef PA_LOADS
}
__device__ __forceinline__ void phase_peer_coef(const Frame& F, const Args& a) {
    unsigned char* ws = a.ws; const float* PA = (const float*)(ws + WS_B); const int* PE = (const int*)(ws + WS_PE); const float* PG = (const float*)(ws + WS_PG);
    const float* US = (const float*)(ws + WS_PT + PT_US); const float* VS = (const float*)(ws + WS_PT + PT_VS); const float* SH = (const float*)(ws + WS_SMALL + 262144);
    signed char* CQ = (signed char*)(ws + WS_HCMP); float* CSC = (float*)(ws + WS_SMALL + 524288);
    const int gw = F.bid * NWAVES + F.wave, NGW = F.G * NWAVES, lane = F.lane;
    for (int tok0 = gw; tok0 < T; tok0 += 4 * NGW) { float s0[4], s1[4]; int e0[4], e1[4]; float sh[4], g0[4], g1[4]; size_t i0[4];
#pragma unroll
        for (int r = 0; r < 4; ++r) { const int tok = (tok0 + r * NGW < T) ? tok0 + r * NGW : tok0; i0[r] = (size_t)tok * 128 + lane; s0[r] = 0.f; s1[r] = 0.f;
#pragma unroll
            for (int sl = 0; sl < 8; ++sl) { s0[r] += PA[(size_t)sl * T * 128 + i0[r]]; s1[r] += PA[(size_t)sl * T * 128 + i0[r] + 64]; }
            e0[r] = PE[i0[r]]; e1[r] = PE[i0[r] + 64]; sh[r] = SH[tok]; g0[r] = PG[i0[r]]; g1[r] = PG[i0[r] + 64]; }
        float u0[4], u1[4], w0[4], w1[4];
#pragma unroll
        for (int r = 0; r < 4; ++r) { u0[r] = US[e0[r]]; u1[r] = US[e1[r]]; w0[r] = VS[e0[r]]; w1[r] = VS[e1[r]]; }
#pragma unroll
        for (int r = 0; r < 4; ++r) { const int tok = tok0 + r * NGW;
            if (tok < T) { const float c0 = g0[r] * gelu_tanh(s0[r] * u0[r] * sh[r]) * w0[r], c1 = g1[r] * gelu_tanh(s1[r] * u1[r] * sh[r]) * w1[r];
                float amax = fmaxf(fabsf(c0), fabsf(c1));
#pragma unroll
                for (int o = 1; o < 64; o <<= 1) amax = fmaxf(amax, __shfl_xor(amax, o));
                const float sc = amax > 0.f ? 127.f / amax : 0.f;
                CQ[i0[r]] = (signed char)(int)__builtin_rintf(c0 * sc); CQ[i0[r] + 64] = (signed char)(int)__builtin_rintf(c1 * sc);
                if (lane == 0) CSC[tok] = amax * (1.f / 127.f); } } }
}
__device__ __forceinline__ void phase_peer_v(const Frame& F, const Args& a, const bool dry) {
    unsigned char* ws = a.ws;
    const unsigned char* V8 = ws + WS_PT + PT_V8; const int* PE = (const int*)(ws + WS_PE); const unsigned* CQ = (const unsigned*)(ws + WS_HCMP); const float* CSC = (const float*)(ws + WS_SMALL + 524288); bf16_t* X = (bf16_t*)(ws + WS_XB);
    const int lane = F.lane, rg = lane >> 4, li = lane & 15, xs = F.vid & 7, rank = F.vid >> 3, nrank = (F.G - xs + 7) >> 3;
    LAS int* lpe = (LAS int*)(F.lds + F.wave * 2048); LAS unsigned* lcq = (LAS unsigned*)(lpe + 128);
    const int dsel = li >> 2, bsh = (li & 3) * 8;
    for (int pass = 0; pass < 2; ++pass) { const int sl = pass * 8 + xs; const unsigned char* Vs = V8 + (size_t)sl * PT_SLICE + li * 16;
        int tok = rank * 8 + F.wave;
        int pn0 = 0, pn1 = 0; unsigned cn = 0u;
        if (tok < T) { pn0 = PE[(size_t)tok * 128 + lane]; pn1 = PE[(size_t)tok * 128 + 64 + lane]; cn = CQ[(size_t)tok * 32 + (lane & 31)]; }
        for (; tok < T; tok += nrank * 8) {
            lpe[lane] = pn0; lpe[64 + lane] = pn1; if (lane < 32) lcq[lane] = cn;
            LDS_WAIT();
            { const int tn = tok + nrank * 8; if (tn < T) { pn0 = PE[(size_t)tn * 128 + lane]; pn1 = PE[(size_t)tn * 128 + 64 + lane]; cn = CQ[(size_t)tn * 32 + (lane & 31)]; } }
            u32x2* xp = (u32x2*)(X + (size_t)tok * D + sl * 256 + li * 16 + rg * 4);
            const u32x2 xb = *xp; const f32x4 xq = {bflo(xb.x), bfhi(xb.x), bflo(xb.y), bfhi(xb.y)};
            const float csc = CSC[tok];
            i32x4 acc = {0, 0, 0, 0};
#pragma unroll
            for (int q8 = 0; q8 < 32 / PS_B; ++q8) { u32x4 w[PS_B]; unsigned cd[PS_B];
#pragma unroll
                for (int j = 0; j < PS_B; ++j) { const int q = q8 * PS_B + j; const int e = lpe[4 * q + rg]; cd[j] = lcq[q]; w[j] = *(const u32x4*)(Vs + (size_t)e * 256); }
#pragma unroll
                for (int j = 0; j < PS_B; ++j) { const unsigned cb = ((cd[j] >> (8 * rg)) & 255u) << bsh;
                    const u32x4 av = {dsel == 0 ? cb : 0u, dsel == 1 ? cb : 0u, dsel == 2 ? cb : 0u, dsel == 3 ? cb : 0u};
                    acc = __builtin_amdgcn_mfma_i32_16x16x64_i8(__builtin_bit_cast(i32x4, av), __builtin_bit_cast(i32x4, w[j]), acc, 0, 0, 0); } }
            if (!dry) { f32x4 x0 = xq; x0.x += (float)acc[0] * csc; x0.y += (float)acc[1] * csc; x0.z += (float)acc[2] * csc; x0.w += (float)acc[3] * csc; *xp = (u32x2){cvtpk(x0.x, x0.y), cvtpk(x0.z, x0.w)}; }
            LDS_WAIT();
        }
    }
}

template <bool OUT_F32>
__device__ __forceinline__ void phase_norm(const Frame& F, const float* X, const float* gain, void* out) {
    const int gw = F.bid * NWAVES + F.wave, NGW = F.G * NWAVES;
    for (int m = gw; m < T; m += NGW) rms_row<OUT_F32>(X + (size_t)m * D, gain, OUT_F32 ? (void*)((float*)out + (size_t)m * D) : (void*)((bf16_t*)out + (size_t)m * D), F.lane);
}

constexpr int NPH = 19;
__global__ void __launch_bounds__(NTHREADS, 2) fwd(Args args) {
    extern __shared__ __attribute__((aligned(16))) unsigned char lds_raw[];
    Frame F; F.lds = (LAS unsigned char*)lds_raw; F.tid = threadIdx.x; F.lane = F.tid & 63; F.wave = __builtin_amdgcn_readfirstlane(F.tid >> 6); F.G = gridDim.x; F.bid = blockIdx.x;
    volatile LAS unsigned* MISC = (volatile LAS unsigned*)(F.lds + MISC_OFF);
    if (F.tid < 32) MISC[F.tid] = 0u;
    __syncthreads();
    unsigned char* ws = args.ws;
    const int lo = args.ph_lo, hi = args.ph_hi;
    XcdBarrier bar; bar.bar = (unsigned*)(ws + WS_CTL) + CW_BAR; bar.x = 0; bar.st = MISC + 8;
    if (hi - lo > 1) bar = xcd_barrier_post((unsigned*)(ws + WS_CTL) + CW_BAR, MISC + 8);
    F.vid = F.bid;
    unsigned* xrank = (unsigned*)(ws + WS_CTL) + 1024;
    if (hi - lo > 1) { if (F.tid == 0) { const unsigned x = xb_xcc_id(); MISC[16] = x; MISC[17] = xb_add(&xrank[64 * x], 1u); } }
#ifndef PH_MASK
#define PH_MASK 0xFFFFFFFFu
#endif
#define IN(k) (lo <= (k) && (k) < hi && ((PH_MASK >> (k)) & 1u))
#define SEAM(k) do { if (IN(k) && IN((k) + 1)) xcd_barrier(bar); } while (0)
#define REPS(k) ((PROBE_DUP == (k)) ? 2 : 1)
    bf16_t* Z = (bf16_t*)(ws + WS_R1);

    if (IN(0)) for (int rep = 0; rep < REPS(0); ++rep) { phase_prologue(F, args); SEAM(0); }
    if (IN(0) && IN(1) && (F.G & 7) == 0) {
        bool okv = true;
        for (int j = 0; j < 16; ++j) { const unsigned c = xb_ld(&xrank[64 * j]); okv = okv && (c == ((j < 8) ? (unsigned)(F.G >> 3) : 0u)); }
        if (okv) F.vid = (int)(MISC[17] * 8u + MISC[16]);
    }
    if (IN(1)) for (int rep = 0; rep < REPS(1); ++rep) {
        pg8::Gemm g{(const bf16_t*)(ws + WS_A), (const bf16_t*)(ws + WS_W_IN), D / 2, D / 2, D / 2}; pg8::Order<0> S; S.init(T / 256, ZW / 256, F.G, F.vid);
        pg8::EpiB<0, true> E{(const float*)(ws + SA_H), (const float*)(ws + SB_IN), Z, ZW, nullptr, nullptr, 0, (const bf16_t*)(ws + WS_ACMP), 0, ZC_Q / 256, ZC_KV / 256, at::CS, nullptr};
        const int side_rows = (F.G == 256) ? PT_SIDE_ROWS : 0;
        TableSide side{&F, &args, (F.vid & 7) % 7, side_rows != 0};
        pg8::gemm_phase<pg8::EpiB<0, true>, pg8::Order<0>, true, true, TableSide>(F.lds, g, S, E, side);
        { const int nwg = (T / 256) * (ZW / 256), rem = nwg % F.G;
          if (rem != 0 && F.vid >= rem) phase_peer_tables(F, args, side_rows, side_rows + PT_EARLY_ROWS, (F.vid - rem) * NWAVES + F.wave, (F.G - rem) * NWAVES);
          else if (rem == 0) phase_peer_tables(F, args, side_rows, side_rows + PT_EARLY_ROWS, F.bid * NWAVES + F.wave, F.G * NWAVES); }
        SEAM(1); }
    if (IN(3)) for (int rep = 0; rep < REPS(3); ++rep) {
        if (F.bid == 0 && F.tid < 256) { const int kv = F.tid >> 7, c = F.tid & 127; const float* part = (const float*)(ws + WS_SMALL + 131072) + (size_t)kv * 32 * 128 + c; float sb = 0.f;
            for (int w = 0; w < 32; ++w) sb += part[w * 128];
            ((float*)(ws + WS_SMALL))[F.tid] = sb; }
        { pg8::Gemm g{Z + ZC_POOL, (const bf16_t*)(ws + WS_W_POOL), 512, ZW, 512}; pg8::Order<1> S; S.init(T / 256, 8, F.G, F.vid);
          pg8::EpiB<1, false, false> E{nullptr, nullptr, (bf16_t*)(ws + WS_A) + (size_t)T * 2048, 2048, args.in[5], nullptr, 0, nullptr, 0, 0, 0, 1.f, nullptr};
          pg8::gemm_phase(F.lds, g, S, E); }
        { pg8::Gemm g{(const bf16_t*)(ws + WS_ACMP), (const bf16_t*)(ws + WS_W_CMP), 2048, 2048, 2048}; pg8::Order<2> S; S.init(16, 2, F.G, F.bid);
          pg8::EpiF<0> E{nullptr, nullptr, (float*)(ws + WS_HCMP), 512, nullptr, nullptr, 0};
          pg8::gemm_phase(F.lds, g, S, E); }
        SEAM(3); }
    if (IN(4)) for (int rep = 0; rep < REPS(4); ++rep) {
        phase_cmp_combine(F, args);
        pool_window_rows(F, (const bf16_t*)(ws + WS_A) + (size_t)T * 2048, ws + WS_A, (float*)(ws + SA_P));
        SEAM(4); }
    if (IN(5)) for (int rep = 0; rep < REPS(5); ++rep) { phase_attention(F, args); SEAM(5); }
    if (IN(6)) for (int rep = 0; rep < REPS(6); ++rep) {
        requant_rows<4>(F, (const bf16_t*)(ws + WS_NSA), ws + WS_ACMP, (const unsigned*)(ws + WS_CTL) + CW_ROWMAX_N, (float*)(ws + SA_N));
        SEAM(6); }
    if (IN(7)) for (int rep = 0; rep < REPS(7); ++rep) {
        { pg8::Gemm g{(const bf16_t*)(ws + WS_A), (const bf16_t*)(ws + WS_W_UPP), 1024, 1024, 1024}; pg8::Order<0> S; S.init(T / 256, D / 256, F.G, F.vid);
          pg8::EpiB<2, true> E{(const float*)(ws + SA_P), (const float*)(ws + SB_UPP), (bf16_t*)(ws + WS_C), D, nullptr, Z + ZC_GP, ZW, nullptr, 0, 0, 0, 1.f, nullptr};
          pg8::gemm_phase(F.lds, g, S, E); }
        { pg8::Gemm g{(const bf16_t*)(ws + WS_ACMP), (const bf16_t*)(ws + WS_W_UPN), 1024, 1024, 1024}; pg8::Order<0> S; S.init(T / 256, D / 256, F.G, F.vid);
          pg8::EpiB<3, true, true> E{(const float*)(ws + SA_N), (const float*)(ws + SB_UPN), (bf16_t*)(ws + WS_D), D, nullptr, Z + ZC_GN, ZW, (const bf16_t*)(ws + WS_C), D, 0, 0, 1.f, (unsigned*)(ws + WS_CTL) + CW_ROWMAX};
          pg8::gemm_phase(F.lds, g, S, E); }
        SEAM(7); }
    if (IN(8)) for (int rep = 0; rep < REPS(8); ++rep) {
        requant_rows<8>(F, (const bf16_t*)(ws + WS_D), ws + WS_C, (const unsigned*)(ws + WS_CTL) + CW_ROWMAX, (float*)(ws + SA_M));
        SEAM(8); }
    if (IN(9)) for (int rep = 0; rep < REPS(9); ++rep) {
        pg8::Gemm g{(const bf16_t*)(ws + WS_C), (const bf16_t*)(ws + WS_W_OUT), D / 2, D / 2, D / 2}; pg8::Order<0> S; S.init(T / 256, D / 256, F.G, F.vid);
        pg8::EpiB<4, true> E{(const float*)(ws + SA_M), (const float*)(ws + SB_OUT), (bf16_t*)(ws + WS_XB), D, args.in[0], nullptr, D, nullptr, 0, 0, 0, 1.f, nullptr};
        pg8::gemm_phase(F.lds, g, S, E);
        SEAM(9); }
    if (IN(10)) for (int rep = 0; rep < REPS(10); ++rep) {
        { const int gw8 = F.bid * NWAVES + F.wave, NGW8 = F.G * NWAVES;
          for (int m = gw8; m < T; m += NGW8) rms_row_i8_b((const bf16_t*)(ws + WS_XB) + (size_t)m * D, args.in[13], ws + WS_NSA + (size_t)m * D, (float*)(ws + WS_SMALL + 262144) + m, F.lane); }
        phase_peer_tables(F, args, ((F.G == 256) ? PT_SIDE_ROWS : 0) + PT_EARLY_ROWS, 32768, F.bid * NWAVES + F.wave, F.G * NWAVES);
        SEAM(10); }
    if (IN(11)) for (int rep = 0; rep < REPS(11); ++rep) {
        { pg8::Gemm g{(const bf16_t*)(ws + WS_NSA), (const bf16_t*)(ws + WS_W_PQ), D / 2, D / 2, D / 2}; pg8::Order<0> S; S.init(T / 256, 2048 / 256, F.G, F.vid);
          pg8::EpiB<0, true> E{(const float*)(ws + WS_SMALL + 262144), (const float*)(ws + SB_PQ), (bf16_t*)(ws + WS_B), 2048, nullptr, nullptr, 0, nullptr, 0, 0, 0, 1.f, nullptr};
          pg8::gemm_phase(F.lds, g, S, E); }
        SEAM(11); }
    if (IN(12)) for (int rep = 0; rep < REPS(12); ++rep) { phase_peer_score(F, args); SEAM(12); }
    if (IN(13)) for (int rep = 0; rep < REPS(13); ++rep) { if (PROBE_DUP == 111) { phase_peer_a(F, args, 8191, (float*)(ws + WS_X)); xcd_barrier(bar); }
        phase_peer_a(F, args, 16383, (float*)(ws + WS_B)); SEAM(13); }
    if (IN(14)) { phase_peer_coef(F, args); SEAM(14); }
    if (IN(15)) for (int rep = 0; rep < REPS(15); ++rep) { phase_peer_v(F, args, rep + 1 < REPS(15)); SEAM(15); }
    if (IN(16)) for (int rep = 0; rep < REPS(16); ++rep) {
        const int gw14 = F.bid * NWAVES + F.wave, NGW14 = F.G * NWAVES;
        for (int m = gw14; m < T; m += NGW14) rms_row_i8_b((const bf16_t*)(ws + WS_XB) + (size_t)m * D, args.in[19], ws + WS_D + (size_t)m * D, (float*)(ws + SA_R) + m, F.lane);
        { pg8::Gemm g{(const bf16_t*)(ws + WS_PBF), (const bf16_t*)(ws + WS_W_PP), 256, 256, 256}; pg8::Order<0> S; S.init(T / 256, D / 256, F.G, F.vid);
          pg8::EpiB<0> E{nullptr, nullptr, (bf16_t*)(ws + WS_A), D, nullptr, nullptr, 0, nullptr, 0, 0, 0, 1.f, nullptr};
          pg8::gemm_phase(F.lds, g, S, E); }
        SEAM(16); }
    if (IN(17)) for (int rep = 0; rep < REPS(17); ++rep) {
        pg8::Gemm g{(const bf16_t*)(ws + WS_D), (const bf16_t*)(ws + WS_W_PG), D / 2, D / 2, D / 2}; pg8::Order<0> S; S.init(T / 256, D / 256, F.G, F.vid);
        if (rep + 1 < REPS(17)) { pg8::EpiF<0, true> E{(const float*)(ws + SA_R), (const float*)(ws + SB_PG), (float*)(ws + WS_X), D, nullptr, nullptr, 0}; pg8::gemm_phase(F.lds, g, S, E); }
        else { pg8::EpiB<5, true> E{(const float*)(ws + SA_R), (const float*)(ws + SB_PG), (bf16_t*)(ws + WS_R1), D, nullptr, (const bf16_t*)(ws + WS_XB), D, (const bf16_t*)(ws + WS_A), D, 0, 0, 1.f, nullptr}; pg8::gemm_phase(F.lds, g, S, E); }
        SEAM(17); }
    if (IN(18)) for (int rep = 0; rep < REPS(18); ++rep) {
        const bf16_t* X3 = (const bf16_t*)(ws + WS_R1); const f32x4* gr = (const f32x4*)args.in[22] + F.lane;
        f32x4 gv[16];
#pragma unroll
        for (int j = 0; j < 16; ++j) gv[j] = gr[64 * j];
        for (int m = F.bid * NWAVES + F.wave; m < T; m += F.G * NWAVES) { const u32x2* xr = (const u32x2*)(X3 + (size_t)m * D) + F.lane; f32x4 v[16]; float ss = 0.f;
#pragma unroll
            for (int j = 0; j < 16; ++j) { const u32x2 q = xr[64 * j]; v[j] = (f32x4){bflo(q.x), bfhi(q.x), bflo(q.y), bfhi(q.y)}; ss += (v[j].x * v[j].x + v[j].y * v[j].y) + (v[j].z * v[j].z + v[j].w * v[j].w); }
            const float rstd = 1.f / sqrtf(wave_sum(ss) * (1.f / D) + RMS_EPS);
            f32x4* orow = (f32x4*)(args.out + (size_t)m * D) + F.lane;
#pragma unroll
            for (int j = 0; j < 16; ++j) orow[64 * j] = v[j] * rstd * gv[j]; } }
#undef IN
#undef SEAM
}

extern "C" void kernel_launch(void* const* d_in, const int* in_sizes, int n_in, void* d_out, int out_size, void* d_ws, size_t ws_size, hipStream_t stream) {
    static int grid = 0;
    if (grid == 0) {
        if (n_in != 23 || out_size != T * D || ws_size < WS_END) { fprintf(stderr, "kernel_launch: unexpected shapes n_in %d out %d ws %zu (need %zu)\n", n_in, out_size, ws_size, (size_t)WS_END); grid = -1; return; }
        int dev = 0, cus = 0, per_cu = 0;
        if (hipGetDevice(&dev) != hipSuccess || hipDeviceGetAttribute(&cus, hipDeviceAttributeMultiprocessorCount, dev) != hipSuccess) { grid = -1; return; }
        if (hipFuncSetAttribute((const void*)fwd, hipFuncAttributeMaxDynamicSharedMemorySize, LDS_BYTES) != hipSuccess) { fprintf(stderr, "kernel_launch: hipFuncSetAttribute failed\n"); grid = -1; return; }
        if (hipOccupancyMaxActiveBlocksPerMultiprocessor(&per_cu, (const void*)fwd, NTHREADS, LDS_BYTES) != hipSuccess || per_cu < 1) fprintf(stderr, "kernel_launch: occupancy query says %d\n", per_cu);
        (void)hipGetLastError();
        grid = cus;
    }
    if (grid < 0) return;
    hipMemsetAsync((char*)d_ws + WS_CTL, 0, CTL_ZERO_BYTES, stream);
    Args a{};
    for (int i = 0; i < 23; ++i) a.in[i] = (const float*)d_in[i];
    a.out = (float*)d_out; a.ws = (unsigned char*)d_ws;
#if MK_MULTI
    for (int ph = 0; ph < NPH; ++ph) { a.ph_lo = ph; a.ph_hi = ph + 1; hipLaunchKernelGGL(fwd, dim3(grid), dim3(NTHREADS), LDS_BYTES, stream, a); }
#else
    a.ph_lo = 0; a.ph_hi = NPH; hipLaunchKernelGGL(fwd, dim3(grid), dim3(NTHREADS), LDS_BYTES, stream, a);
#endif
}
```

```cpp
#include <hip/hip_runtime.h>
#include <cstdio>
#include <cstdint>

#ifndef MK_MULTI
#define MK_MULTI 0
#endif
#ifndef PROBE_DUP
#define PROBE_DUP -1
#endif
#define PT_SIDE_ROWS 16384
#ifndef PT_EARLY_ROWS
#define PT_EARLY_ROWS 12288
#endif
#ifndef PS_B
#define PS_B 32
#endif
#ifndef PE_UN
#define PE_UN 4
#endif

#define GAS __attribute__((address_space(1)))
#define LAS __attribute__((address_space(3)))
typedef unsigned short bf16_t;
typedef short bf16x8 __attribute__((ext_vector_type(8)));
typedef short s16x4 __attribute__((ext_vector_type(4)));
typedef float f32x4 __attribute__((ext_vector_type(4)));
typedef float f32x2 __attribute__((ext_vector_type(2)));
typedef float f32x16 __attribute__((ext_vector_type(16)));
typedef unsigned u32x4 __attribute__((ext_vector_type(4)));
typedef unsigned u32x2 __attribute__((ext_vector_type(2)));
typedef int i32x4 __attribute__((ext_vector_type(4)));

constexpr int T = 8192, D = 4096;
constexpr int ZW = 15616;
constexpr int ZC_POOL = 0, ZC_Q = 2048, ZC_KV = 4096, ZC_G = 7168, ZC_GP = 7424, ZC_GN = 11520;
constexpr int IN_W = 15408;
constexpr int NTHREADS = 512, NWAVES = 8;
constexpr float RMS_EPS = 1e-6f;

constexpr size_t MiB = 1u << 20;
constexpr size_t WS_CTL = 0, CTL_ZERO_BYTES = 1 * MiB;
constexpr size_t WS_W_IN = 2 * MiB;
constexpr size_t WS_W_UPP = 124 * MiB;
constexpr size_t WS_W_UPN = 140 * MiB;
constexpr size_t WS_W_OUT = 156 * MiB;
constexpr size_t WS_W_PQ = 188 * MiB;
constexpr size_t WS_W_PG = 204 * MiB;
constexpr size_t WS_W_PP = 236 * MiB;
constexpr size_t WS_W_POOL = 238 * MiB;
constexpr size_t WS_W_CMP = 240 * MiB;
constexpr size_t WS_SMALL = 242 * MiB;
constexpr size_t WS_R1 = 244 * MiB;
constexpr size_t WS_X = 500 * MiB;
constexpr size_t WS_XB = 244 * MiB + 64 * MiB;
constexpr size_t WS_A = 628 * MiB;
constexpr size_t WS_B = 692 * MiB;
constexpr size_t WS_C = 756 * MiB;
constexpr size_t WS_D = 820 * MiB;
constexpr size_t WS_NSA = 884 * MiB;
constexpr size_t WS_ACMP = 916 * MiB;
constexpr size_t WS_HCMP = 932 * MiB;
constexpr size_t WS_KCVC = 940 * MiB;
constexpr size_t WS_PE = 942 * MiB;
constexpr size_t WS_PG = 946 * MiB;
constexpr size_t WS_PBF = 950 * MiB;
constexpr size_t WS_PT = 954 * MiB;
constexpr size_t WS_END = 1083 * MiB;

constexpr int CW_BAR = 4096;

constexpr int LDS_BYTES = 147456;
constexpr int MISC_OFF = 131072 + 8192;

#define LDS_WAIT() asm volatile("s_waitcnt lgkmcnt(0)" ::: "memory")
#define VM_WAIT() asm volatile("s_waitcnt vmcnt(0)" ::: "memory")
__device__ __forceinline__ unsigned f2bf(float f) { unsigned u = __builtin_bit_cast(unsigned, f); return (u + 0x7fffu + ((u >> 16) & 1u)) >> 16; }
__device__ __forceinline__ unsigned pk2(float lo, float hi) { return f2bf(lo) | (f2bf(hi) << 16); }
__device__ __forceinline__ unsigned cvtpk(float lo, float hi) { unsigned r; asm volatile("v_cvt_pk_bf16_f32 %0, %1, %2" : "=v"(r) : "v"(lo), "v"(hi)); return r; }
__device__ __forceinline__ float bflo(unsigned u) { return __builtin_bit_cast(float, u << 16); }
__device__ __forceinline__ float bfhi(unsigned u) { return __builtin_bit_cast(float, u & 0xffff0000u); }
__device__ __forceinline__ float bf2f(bf16_t b) { return __builtin_bit_cast(float, (unsigned)b << 16); }
__device__ __forceinline__ float sigmoidf_(float x) { return __builtin_amdgcn_rcpf(1.f + __builtin_amdgcn_exp2f(-1.4426950408889634f * x)); }
__device__ __forceinline__ float wave_sum(float v) {
#pragma unroll
    for (int o = 1; o < 64; o <<= 1) v += __shfl_xor(v, o);
    return v;
}

#define XB_TMO      128
#define XB_XCNT(j)  (256  + 64 * (j))
#define XB_XSUB(j)  (1280 + 64 * (j))
#define XB_XGEN(j)  (2304 + 64 * (j))
#define XB_TOP      3328
#define XB_TOPGEN   3392
#define XCD_BAR_WORDS 3456
#define XB_SPIN_CAP (1u << 18)

__device__ __forceinline__ unsigned xb_ld(unsigned* p)              { return __hip_atomic_load(p, __ATOMIC_RELAXED, __HIP_MEMORY_SCOPE_AGENT); }
__device__ __forceinline__ unsigned xb_add(unsigned* p, unsigned v) { return __hip_atomic_fetch_add(p, v, __ATOMIC_RELAXED, __HIP_MEMORY_SCOPE_AGENT); }
__device__ __forceinline__ unsigned xb_xcc_id() { return (unsigned)__builtin_amdgcn_s_getreg((3 << 11) | 20) & 0xFu; }
#define XB_SPIN(cond, bar) do { unsigned _sp = 0; while (cond) { __builtin_amdgcn_s_sleep(1); \
    if ((++_sp & 255u) == 0u) { if (xb_ld(&(bar)[XB_TMO])) break; if (_sp > XB_SPIN_CAP) { atomicAdd(&(bar)[XB_TMO], 1u); break; } } } } while (0)

struct XcdBarrier { unsigned* bar; unsigned x; volatile LAS unsigned* st; };

__device__ __forceinline__ XcdBarrier xcd_barrier_post(unsigned* bar, volatile LAS unsigned* st) {
    XcdBarrier b; b.bar = bar; b.x = xb_xcc_id(); b.st = st;
    if (threadIdx.x == 0) (void)xb_add(&bar[XB_XCNT(b.x)], 1u);
    return b;
}
__device__ __forceinline__ void xcd_barrier_complete(unsigned* bar, unsigned x, unsigned& nloc, unsigned& nx) {
    const unsigned G = gridDim.x * gridDim.y * gridDim.z;
    unsigned sum, cnt, mine, sp = 0u;
    for (;;) {
        sum = 0u; cnt = 0u; mine = 0u;
#pragma unroll
        for (unsigned j = 0; j < 16; ++j) { const unsigned c = xb_ld(&bar[XB_XCNT(j)]); sum += c; cnt += (c > 0u) ? 1u : 0u; mine = (j == x) ? c : mine; }
        if (sum == G) break;
        __builtin_amdgcn_s_sleep(1);
        if ((++sp & 255u) == 0u) { if (xb_ld(&bar[XB_TMO])) break; if (sp > XB_SPIN_CAP) { atomicAdd(&bar[XB_TMO], 1u); break; } }
    }
    nloc = mine > 0u ? mine : 1u; nx = cnt > 0u ? cnt : 1u;
}
__device__ __forceinline__ void xcd_barrier(const XcdBarrier& b) {
    asm volatile("s_waitcnt vmcnt(0)" ::: "memory");
    __syncthreads();
    if (threadIdx.x == 0) {
        unsigned* bar = b.bar;
        __builtin_amdgcn_s_waitcnt(0);
        unsigned nloc = b.st[0], nx = b.st[1];
        if (nloc == 0u) { xcd_barrier_complete(bar, b.x, nloc, nx); b.st[0] = nloc; b.st[1] = nx; }
        const unsigned old = xb_add(&bar[XB_XSUB(b.x)], 1u);
        const unsigned gen = old / nloc;
        if (old + 1u == (gen + 1u) * nloc) {
            __builtin_amdgcn_fence(__ATOMIC_RELEASE, "agent");
            asm volatile("s_waitcnt vmcnt(0)" ::: "memory");
            const unsigned og = xb_add(&bar[XB_TOP], 1u);
            const unsigned tg = og / nx;
            if (og + 1u == (tg + 1u) * nx) xb_add(&bar[XB_TOPGEN], 1u);
            else XB_SPIN(xb_ld(&bar[XB_TOPGEN]) == tg, bar);
            __builtin_amdgcn_fence(__ATOMIC_ACQUIRE, "agent");
            xb_add(&bar[XB_XGEN(b.x)], 1u);
            asm volatile("s_waitcnt vmcnt(0)" ::: "memory");
        } else {
            XB_SPIN(xb_ld(&bar[XB_XGEN(b.x)]) == gen, bar);
            __builtin_amdgcn_fence(__ATOMIC_ACQUIRE, "agent");
            asm volatile("s_waitcnt vmcnt(0)" ::: "memory");
        }
    }
    __syncthreads();
}

namespace pg8 {
constexpr int BM = 256, BK = 64, HALF = 128, HTB = HALF * BK * 2, STAGE_BYTES = 8 * HTB, NXCD = 8, WGM = 8;
__host__ __device__ __forceinline__ int lds_byte(int r, int c) { const int st = (r >> 4) * 2 + (c >> 5), rr = r & 15, cc = c & 31, ob = rr * 64 + cc * 2; return st * 1024 + (ob ^ (((ob >> 9) & 1) << 5)); }
__host__ __device__ __forceinline__ void stage_rc(int b, int& R, int& C) { const int st = b / 1024, sb = b % 1024, swz = sb ^ (((sb >> 9) & 1) << 5); R = (st >> 1) * 16 + swz / 64; C = (st & 1) * 32 + (swz % 64) / 2; }
__host__ __device__ __forceinline__ int perm32(int rho) { const int n = rho >> 4, i = rho & 15; return 8 * (i >> 2) + 4 * n + (i & 3); }

struct Unit { int pm, pn; };
struct Gemm { const bf16_t* A; const bf16_t* Bt; int K, lda, ldb; };

template <int MODE> struct Order {
    int nM, nN, nwg, G, c;
    __device__ void init(int nM_, int nN_, int G_, int c_) { nM = nM_; nN = nN_; nwg = (MODE == 2) ? 16 : nM * nN; G = G_; c = c_; }
    __device__ bool next(int i, Unit& u) const {
        const long L = (long)i * G + c; if (L >= nwg) return false;
        if (MODE == 2) { u.pm = (int)L; u.pn = (int)L >> 3; return true; }
        int wgid = (int)L; { const int q = nwg / NXCD, r = nwg % NXCD, xcd = wgid % NXCD, off = wgid / NXCD; wgid = (xcd < r ? xcd * (q + 1) : r * (q + 1) + (xcd - r) * q) + off; }
        const int nig = WGM * nN, gid = wgid / nig, fm = gid * WGM, gsz = (nM - fm) < WGM ? (nM - fm) : WGM;
        u.pm = fm + ((wgid % nig) % gsz); u.pn = (wgid % nig) / gsz; return true;
    }
    __device__ __forceinline__ size_t a_off(const Unit& u, const Gemm& g) const { size_t o = (size_t)u.pm * BM * g.lda * 2; if (MODE == 1) o += (size_t)(u.pn >> 1) * 512 * 2; return o; }
    __device__ __forceinline__ size_t b_off(const Unit& u, const Gemm& g) const { return (size_t)u.pn * BM * g.ldb * 2; }
};

struct NoSide { static constexpr bool ON = false; __device__ void after(int) const {} };
template <class Epi, class Sched, bool ALIGN_EPI = true, bool SP2 = true, class Side = NoSide>
__device__ __forceinline__ void gemm_phase(LAS unsigned char* lds, const Gemm g, const Sched& S, const Epi& E, const Side side = Side()) {
    constexpr bool I8 = Epi::I8;
    const int tid = threadIdx.x, wid = __builtin_amdgcn_readfirstlane(tid >> 6), lane = tid & 63, wr = wid >> 2, wc = wid & 3, fr = lane & 15, fq = lane >> 4;
    const int K = g.K, nt = K / BK;
    unsigned voffA[2], voffB[2];
#pragma unroll
    for (int i = 0; i < 2; ++i) { int R, C; stage_rc(tid * 16 + i * 8192, R, C); const int Rb = Epi::PERM ? ((R & ~31) + perm32(R & 31)) : R;
        voffA[i] = (unsigned)(R * g.lda + C) * 2u; voffB[i] = (unsigned)(Rb * g.ldb + C) * 2u; }
    const size_t kstep = (size_t)(BK * 2);
    const size_t hstepA = (size_t)HALF * g.lda * 2, hstepB = (size_t)HALF * g.ldb * 2;
    const unsigned ldsw = (unsigned)wid * 1024u;
    const int aoff = lds_byte(wr * 64 + fr, fq * 8), boff = lds_byte(wc * 32 + fr, fq * 8);
#define PG8_SA(b, h) (((b) * 2 + (h)) * HTB)
#define PG8_SB(b, h) ((4 + (b) * 2 + (h)) * HTB)
#define PG8_STAGE(bufoff, gbase, voff) do { _Pragma("unroll") for (int _i = 0; _i < 2; ++_i) \
        __builtin_amdgcn_global_load_lds((const unsigned*)((const char*)(gbase) + (voff)[_i]), (LAS unsigned*)(lds + (bufoff) + ldsw + _i * 8192), 16, 0, 0); } while (0)
#define PG8_LDA(dst, b, h) do { _Pragma("unroll") for (int m = 0; m < 4; ++m) _Pragma("unroll") for (int k = 0; k < 2; ++k) dst[m][k] = *(const LAS bf16x8*)(lds + PG8_SA(b, h) + aoff + m * 2048 + k * 1024); } while (0)
#define PG8_LDB(dst, b, h) do { _Pragma("unroll") for (int n = 0; n < 2; ++n) _Pragma("unroll") for (int k = 0; k < 2; ++k) dst[n][k] = *(const LAS bf16x8*)(lds + PG8_SB(b, h) + boff + n * 2048 + k * 1024); } while (0)
#define PG8_MMA(ai, bj, At, Bt) do { __builtin_amdgcn_s_setprio(1); _Pragma("unroll") for (int m = 0; m < 4; ++m) _Pragma("unroll") for (int n = 0; n < 2; ++n) _Pragma("unroll") for (int k = 0; k < 2; ++k) { \
        if constexpr (I8) acc[ai][bj][m][n] = __builtin_bit_cast(f32x4, __builtin_amdgcn_mfma_i32_16x16x64_i8(__builtin_bit_cast(i32x4, Bt[n][k]), __builtin_bit_cast(i32x4, At[m][k]), __builtin_bit_cast(i32x4, acc[ai][bj][m][n]), 0, 0, 0)); \
        else acc[ai][bj][m][n] = __builtin_amdgcn_mfma_f32_16x16x32_bf16(Bt[n][k], At[m][k], acc[ai][bj][m][n], 0, 0, 0); } __builtin_amdgcn_s_setprio(0); } while (0)
#define PG8_WAIT_V(n) asm volatile("s_waitcnt vmcnt(" #n ")" ::: "memory")
#define PG8_WAIT_L(n) asm volatile("s_waitcnt lgkmcnt(" #n ")" ::: "memory")
#define PG8_BAR __builtin_amdgcn_s_barrier()
#define PG8_SCHED __builtin_amdgcn_sched_barrier(0)
    Unit cur, nxt; int ui = 0;
    if (!S.next(0, cur)) return;
    f32x4 acc[2][2][4][2];
#pragma unroll
    for (int a = 0; a < 2; ++a)
#pragma unroll
        for (int b = 0; b < 2; ++b)
#pragma unroll
            for (int m = 0; m < 4; ++m)
#pragma unroll
                for (int n = 0; n < 2; ++n) acc[a][b][m][n] = (f32x4){0.f, 0.f, 0.f, 0.f};
    bf16x8 At[4][2], B0[2][2], B1[2][2];
    const char* cA = (const char*)g.A + S.a_off(cur, g); const char* cB = (const char*)g.Bt + S.b_off(cur, g);
    if constexpr (SP2) {
        PG8_STAGE(PG8_SB(0, 0), cB, voffB); PG8_STAGE(PG8_SB(0, 1), cB + hstepB, voffB); PG8_STAGE(PG8_SA(0, 0), cA, voffA); PG8_STAGE(PG8_SA(0, 1), cA + hstepA, voffA);
        if (wr == 1) PG8_BAR;
        PG8_WAIT_V(2); PG8_BAR;
        PG8_STAGE(PG8_SB(1, 0), cB + kstep, voffB); PG8_STAGE(PG8_SA(1, 0), cA + kstep, voffA); PG8_STAGE(PG8_SB(1, 1), cB + hstepB + kstep, voffB);
        PG8_WAIT_V(6); PG8_BAR;
    } else {
        PG8_STAGE(PG8_SB(0, 0), cB, voffB); PG8_STAGE(PG8_SA(0, 0), cA, voffA); PG8_STAGE(PG8_SB(0, 1), cB + hstepB, voffB); PG8_STAGE(PG8_SA(0, 1), cA + hstepA, voffA);
        if (wr == 1) PG8_BAR;
        PG8_WAIT_V(4); PG8_BAR;
        PG8_STAGE(PG8_SB(1, 0), cB + kstep, voffB); PG8_STAGE(PG8_SA(1, 0), cA + kstep, voffA); PG8_STAGE(PG8_SB(1, 1), cB + hstepB + kstep, voffB);
        PG8_WAIT_V(6); PG8_BAR;
    }
    for (;;) {
        const bool has_next = S.next(ui + 1, nxt);
        const char* nA = has_next ? (const char*)g.A + S.a_off(nxt, g) : cA; const char* nB = has_next ? (const char*)g.Bt + S.b_off(nxt, g) : cB;
#pragma unroll 1
        for (int t = 0; t < nt; t += 2) {
            const bool last = (t == nt - 2);
            const char* a1 = cA + (size_t)(t + 1) * kstep;
            const char* a2 = last ? nA : cA + (size_t)(t + 2) * kstep; const char* b2 = last ? nB : cB + (size_t)(t + 2) * kstep;
            const char* a3 = a2 + kstep; const char* b3 = b2 + kstep;
            const bool after_epi = Epi::LOADS && t == 0 && ui > 0;
            if constexpr (SP2) {
            PG8_LDB(B0, 0, 0); PG8_LDB(B1, 0, 1); PG8_SCHED; PG8_LDA(At, 0, 0); PG8_STAGE(PG8_SA(1, 1), a1 + hstepA, voffA);
            if (!after_epi) PG8_WAIT_V(8);
            PG8_WAIT_L(0); PG8_BAR; PG8_MMA(0, 0, At, B0); PG8_MMA(0, 1, At, B1); PG8_BAR; PG8_SCHED;
            PG8_LDA(At, 0, 1); PG8_STAGE(PG8_SB(0, 0), b2, voffB); PG8_STAGE(PG8_SB(0, 1), b2 + hstepB, voffB); PG8_STAGE(PG8_SA(0, 0), a2, voffA);
            if (!after_epi) PG8_WAIT_V(8);
            PG8_WAIT_L(0); PG8_BAR; PG8_MMA(1, 0, At, B0); PG8_MMA(1, 1, At, B1); PG8_BAR; PG8_SCHED;
            PG8_LDB(B0, 1, 0); PG8_LDB(B1, 1, 1); PG8_SCHED; PG8_LDA(At, 1, 0); PG8_STAGE(PG8_SA(0, 1), a2 + hstepA, voffA);
            PG8_WAIT_V(8); PG8_WAIT_L(0); PG8_BAR; PG8_MMA(0, 0, At, B0); PG8_MMA(0, 1, At, B1); PG8_BAR; PG8_SCHED;
            PG8_LDA(At, 1, 1); PG8_STAGE(PG8_SB(1, 0), b3, voffB); PG8_STAGE(PG8_SB(1, 1), b3 + hstepB, voffB); PG8_STAGE(PG8_SA(1, 0), a3, voffA);
            PG8_WAIT_V(8); PG8_WAIT_L(0); PG8_BAR; PG8_MMA(1, 0, At, B0); PG8_MMA(1, 1, At, B1); PG8_BAR; PG8_SCHED;
            } else {
            PG8_LDB(B0, 0, 0); PG8_SCHED; PG8_LDA(At, 0, 0); PG8_STAGE(PG8_SA(1, 1), a1 + hstepA, voffA);
            PG8_WAIT_L(8); PG8_BAR; PG8_WAIT_L(0); PG8_MMA(0, 0, At, B0); PG8_BAR; PG8_SCHED;
            PG8_LDB(B1, 0, 1); PG8_STAGE(PG8_SB(0, 0), b2, voffB);
            PG8_BAR; PG8_WAIT_L(0); PG8_MMA(0, 1, At, B1); PG8_BAR;
            PG8_LDA(At, 0, 1); PG8_STAGE(PG8_SA(0, 0), a2, voffA);
            PG8_BAR; PG8_WAIT_L(0); PG8_MMA(1, 0, At, B0); PG8_BAR; PG8_SCHED;
            PG8_STAGE(PG8_SB(0, 1), b2 + hstepB, voffB);
            PG8_WAIT_V(6); PG8_BAR; PG8_MMA(1, 1, At, B1); PG8_BAR;
            PG8_LDB(B0, 1, 0); PG8_SCHED; PG8_LDA(At, 1, 0); PG8_STAGE(PG8_SA(0, 1), a2 + hstepA, voffA);
            PG8_WAIT_L(8); PG8_BAR; PG8_WAIT_L(0); PG8_MMA(0, 0, At, B0); PG8_BAR; PG8_SCHED;
            PG8_LDB(B1, 1, 1); PG8_STAGE(PG8_SB(1, 0), b3, voffB);
            PG8_BAR; PG8_WAIT_L(0); PG8_MMA(0, 1, At, B1); PG8_BAR;
            PG8_LDA(At, 1, 1); PG8_STAGE(PG8_SA(1, 0), a3, voffA);
            PG8_BAR; PG8_WAIT_L(0); PG8_MMA(1, 0, At, B0); PG8_BAR; PG8_SCHED;
            PG8_STAGE(PG8_SB(1, 1), b3 + hstepB, voffB);
            PG8_WAIT_V(6); PG8_BAR; PG8_MMA(1, 1, At, B1); PG8_BAR;
            }
        }
        if constexpr (ALIGN_EPI) { if (wr == 0) PG8_BAR; }
        E(acc, cur, wr, wc, fr, fq);
        if constexpr (Side::ON) side.after(ui);
        if (!has_next) break;
#pragma unroll
        for (int a = 0; a < 2; ++a)
#pragma unroll
            for (int b = 0; b < 2; ++b)
#pragma unroll
                for (int m = 0; m < 4; ++m)
#pragma unroll
                    for (int n = 0; n < 2; ++n) acc[a][b][m][n] = (f32x4){0.f, 0.f, 0.f, 0.f};
        cur = nxt; cA = nA; cB = nB; ++ui;
        if constexpr (ALIGN_EPI) { if (wr == 1) PG8_BAR; }
    }
    PG8_WAIT_V(0);
    if constexpr (!ALIGN_EPI) { if (wr == 0) PG8_BAR; }
    PG8_BAR;
#undef PG8_SA
#undef PG8_SB
#undef PG8_STAGE
#undef PG8_LDA
#undef PG8_LDB
#undef PG8_MMA
#undef PG8_WAIT_V
#undef PG8_WAIT_L
#undef PG8_BAR
#undef PG8_SCHED
}

template <int MODE, bool QI8 = false, bool RMAX = false> struct EpiB {
    static constexpr bool PERM = true, I8 = QI8, LOADS = QI8 || MODE != 0;
    const float* sa; const float* sb;
    bf16_t* O; int ldo; const float* colscale; const bf16_t* gate; int ldg; const bf16_t* aux; int ldaux; int sc_lo, sc_hi; float sc;
    unsigned* rowmax;
    __device__ __forceinline__ void operator()(const f32x4 (&acc)[2][2][4][2], const Unit& u, int wr, int wc, int fr, int fq) const {
        const int row0 = u.pm * BM + wr * 64 + fr, col0 = u.pn * BM + wc * 32 + 8 * fq;
        const float tsc = (MODE == 0 && u.pn >= sc_lo && u.pn < sc_hi) ? sc : 1.f;
        float ra[2][4]; f32x4 cb[2][2];
        if (QI8) {
#pragma unroll
            for (int ai = 0; ai < 2; ++ai)
#pragma unroll
                for (int m = 0; m < 4; ++m) ra[ai][m] = sa[row0 + ai * HALF + m * 16];
#pragma unroll
            for (int bj = 0; bj < 2; ++bj) { cb[bj][0] = *(const f32x4*)(sb + col0 + bj * HALF) * tsc; cb[bj][1] = *(const f32x4*)(sb + col0 + bj * HALF + 4) * tsc; } }
        else if (MODE == 1) {
#pragma unroll
            for (int bj = 0; bj < 2; ++bj) { cb[bj][0] = *(const f32x4*)(colscale + col0 + bj * HALF); cb[bj][1] = *(const f32x4*)(colscale + col0 + bj * HALF + 4); } }
        const bool dual = (MODE == 0) && aux != nullptr && u.pn >= ZC_KV / 256 && u.pn < ZC_KV / 256 + 4;
        u32x4 gq[2][2], aq[2][2]; f32x4 rs[2][2][2];
#define EPB_LOAD(k) do { if (MODE == 2 || MODE == 3 || MODE == 5) { _Pragma("unroll") for (int bj = 0; bj < 2; ++bj) { const int row_ = row0 + ((k) >> 2) * HALF + ((k) & 3) * 16, col_ = col0 + bj * HALF; \
            gq[(k) & 1][bj] = *(const u32x4*)(gate + (size_t)row_ * ldg + col_); if (MODE == 3 || MODE == 5) aq[(k) & 1][bj] = *(const u32x4*)(aux + (size_t)row_ * ldaux + col_); } } \
        if (MODE == 4) { _Pragma("unroll") for (int bj = 0; bj < 2; ++bj) { const float* rp_ = colscale + (size_t)(row0 + ((k) >> 2) * HALF + ((k) & 3) * 16) * ldg + col0 + bj * HALF; \
            rs[(k) & 1][bj][0] = *(const f32x4*)rp_; rs[(k) & 1][bj][1] = *(const f32x4*)(rp_ + 4); } } } while (0)
        EPB_LOAD(0);
#pragma unroll
        for (int kb = 0; kb < 8; ++kb) { const int ai = kb >> 2, m = kb & 3;
            if (kb < 7) EPB_LOAD(kb + 1);
            { const int row = row0 + ai * HALF + m * 16; float rmx = 0.f;
#pragma unroll
                for (int bj = 0; bj < 2; ++bj) { const int col = col0 + bj * HALF; f32x4 v0 = acc[ai][bj][m][0], v1 = acc[ai][bj][m][1];
                    if (QI8) { const f32x4 c0 = cb[bj][0] * ra[ai][m], c1 = cb[bj][1] * ra[ai][m]; const i32x4 i0 = __builtin_bit_cast(i32x4, v0), i1 = __builtin_bit_cast(i32x4, v1);
                        v0 = (f32x4){(float)i0[0], (float)i0[1], (float)i0[2], (float)i0[3]} * c0; v1 = (f32x4){(float)i1[0], (float)i1[1], (float)i1[2], (float)i1[3]} * c1; }
                    else if (MODE == 0) { v0 = v0 * tsc; v1 = v1 * tsc; }
                    if (!QI8 && MODE == 1) { v0 = v0 * cb[bj][0]; v1 = v1 * cb[bj][1]; }
                    if (MODE == 2 || MODE == 3) { const u32x4 g = gq[kb & 1][bj];
                        f32x4 g0 = {sigmoidf_(bflo(g.x)), sigmoidf_(bfhi(g.x)), sigmoidf_(bflo(g.y)), sigmoidf_(bfhi(g.y))};
                        f32x4 g1 = {sigmoidf_(bflo(g.z)), sigmoidf_(bfhi(g.z)), sigmoidf_(bflo(g.w)), sigmoidf_(bfhi(g.w))};
                        v0 = v0 * g0; v1 = v1 * g1;
                        if (MODE == 3) { const u32x4 q = aq[kb & 1][bj];
                            v0 = v0 + (f32x4){bflo(q.x), bfhi(q.x), bflo(q.y), bfhi(q.y)}; v1 = v1 + (f32x4){bflo(q.z), bfhi(q.z), bflo(q.w), bfhi(q.w)}; } }
                    if (MODE == 4) { v0 = v0 + rs[kb & 1][bj][0]; v1 = v1 + rs[kb & 1][bj][1]; }
                    if (MODE == 5) { const u32x4 c = gq[kb & 1][bj], q = aq[kb & 1][bj];
                        v0 = (f32x4){bflo(c.x) + sigmoidf_(v0[0]) * bflo(q.x), bfhi(c.x) + sigmoidf_(v0[1]) * bfhi(q.x), bflo(c.y) + sigmoidf_(v0[2]) * bflo(q.y), bfhi(c.y) + sigmoidf_(v0[3]) * bfhi(q.y)};
                        v1 = (f32x4){bflo(c.z) + sigmoidf_(v1[0]) * bflo(q.z), bfhi(c.z) + sigmoidf_(v1[1]) * bfhi(q.z), bflo(c.w) + sigmoidf_(v1[2]) * bflo(q.w), bfhi(c.w) + sigmoidf_(v1[3]) * bfhi(q.w)}; }
                    u32x4 w; w.x = cvtpk(v0[0], v0[1]); w.y = cvtpk(v0[2], v0[3]); w.z = cvtpk(v1[0], v1[1]); w.w = cvtpk(v1[2], v1[3]);
                    *(u32x4*)(O + (size_t)row * ldo + col) = w;
                    if (MODE == 0) { if (dual) { const int kc = col - ZC_KV;
                        *(u32x4*)((bf16_t*)aux + (size_t)((kc >> 7) * 512 + (row >> 4)) * 2048 + (row & 15) * 128 + (kc & 127)) = w; } }
                    if (RMAX) rmx = fmaxf(rmx, fmaxf(fmaxf(fmaxf(fabsf(bflo(w.x)), fabsf(bfhi(w.x))), fmaxf(fabsf(bflo(w.y)), fabsf(bfhi(w.y)))), fmaxf(fmaxf(fabsf(bflo(w.z)), fabsf(bfhi(w.z))), fmaxf(fabsf(bflo(w.w)), fabsf(bfhi(w.w)))))); }
                if (RMAX) { rmx = fmaxf(rmx, __shfl_xor(rmx, 16)); rmx = fmaxf(rmx, __shfl_xor(rmx, 32)); if (fq == 0) atomicMax(rowmax + row, __float_as_uint(rmx)); } } }
#undef EPB_LOAD
    }
};
template <int MODE, bool QI8 = false> struct EpiF {
    static constexpr bool PERM = false, I8 = QI8, LOADS = QI8 || MODE != 0;
    const float* sa; const float* sb;
    float* C; int ldc; const float* res; const bf16_t* aux; int ldaux;
    __device__ __forceinline__ void operator()(const f32x4 (&acc)[2][2][4][2], const Unit& u, int wr, int wc, int fr, int fq) const {
        const int row0 = u.pm * BM + wr * 64 + fr, col0 = u.pn * BM + wc * 32 + 4 * fq;
        float ra[2][4]; f32x4 cb[2][2];
        if (QI8) {
#pragma unroll
            for (int ai = 0; ai < 2; ++ai)
#pragma unroll
                for (int m = 0; m < 4; ++m) ra[ai][m] = sa[row0 + ai * HALF + m * 16];
#pragma unroll
            for (int bj = 0; bj < 2; ++bj)
#pragma unroll
                for (int n = 0; n < 2; ++n) cb[bj][n] = *(const f32x4*)(sb + col0 + bj * HALF + n * 16); }
        f32x4 rs[2][2][2]; u32x2 aq[2][2][2], cq[2][2][2];
#define EPF_LOAD(k) do { if (MODE == 1 || MODE == 5 || MODE == 4) { _Pragma("unroll") for (int bj = 0; bj < 2; ++bj) { _Pragma("unroll") for (int n = 0; n < 2; ++n) { \
            const int row_ = row0 + ((k) >> 2) * HALF + ((k) & 3) * 16, col_ = col0 + bj * HALF + n * 16; \
            if (MODE == 4) { aq[(k) & 1][bj][n] = *(const u32x2*)(aux + (size_t)row_ * ldaux + col_); cq[(k) & 1][bj][n] = *(const u32x2*)((const bf16_t*)C + (size_t)row_ * ldc + col_); } \
            else rs[(k) & 1][bj][n] = *(const f32x4*)(res + (size_t)row_ * ldc + col_); } } } } while (0)
        EPF_LOAD(0);
#pragma unroll
        for (int kb = 0; kb < 8; ++kb) { const int ai = kb >> 2, m = kb & 3;
            if (kb < 7) EPF_LOAD(kb + 1);
            { const int row = row0 + ai * HALF + m * 16;
#pragma unroll
                for (int bj = 0; bj < 2; ++bj)
#pragma unroll
                    for (int n = 0; n < 2; ++n) { const int col = col0 + bj * HALF + n * 16; f32x4 v = acc[ai][bj][m][n];
                        if (QI8) { const i32x4 iv = __builtin_bit_cast(i32x4, v); v = (f32x4){(float)iv[0], (float)iv[1], (float)iv[2], (float)iv[3]} * (cb[bj][n] * ra[ai][m]); }
                        if (MODE == 1 || MODE == 5) v = v + rs[kb & 1][bj][n];
                        if (MODE == 5) { *(u32x2*)((bf16_t*)aux + (size_t)row * ldaux + col) = (u32x2){cvtpk(v[0], v[1]), cvtpk(v[2], v[3])}; continue; }
                        if (MODE == 4) { const u32x2 a2 = aq[kb & 1][bj][n], c2 = cq[kb & 1][bj][n];
                            v = (f32x4){bflo(c2.x) + sigmoidf_(v[0]) * bflo(a2.x), bfhi(c2.x) + sigmoidf_(v[1]) * bfhi(a2.x), bflo(c2.y) + sigmoidf_(v[2]) * bflo(a2.y), bfhi(c2.y) + sigmoidf_(v[3]) * bfhi(a2.y)};
                            *(u32x2*)((bf16_t*)res + (size_t)row * ldc + col) = (u32x2){cvtpk(v[0], v[1]), cvtpk(v[2], v[3])}; continue; }
                        if (MODE == 2) { const u32x2 a2 = *(const u32x2*)(aux + (size_t)row * ldaux + col); const f32x4 c0 = *(const f32x4*)(C + (size_t)row * ldc + col);
                            v = c0 + (f32x4){sigmoidf_(v[0]) * bflo(a2.x), sigmoidf_(v[1]) * bfhi(a2.x), sigmoidf_(v[2]) * bflo(a2.y), sigmoidf_(v[3]) * bfhi(a2.y)}; }
                        if (MODE == 3) { const u32x2 a2 = *(const u32x2*)(aux + (size_t)row * ldaux + col); const f32x4 c0 = *(const f32x4*)(C + (size_t)row * ldc + col);
                            v = c0 + (f32x4){sigmoidf_(v[0]) * bflo(a2.x), sigmoidf_(v[1]) * bfhi(a2.x), sigmoidf_(v[2]) * bflo(a2.y), sigmoidf_(v[3]) * bfhi(a2.y)};
                            *(u32x2*)((bf16_t*)res + (size_t)row * ldc + col) = (u32x2){cvtpk(v[0], v[1]), cvtpk(v[2], v[3])}; }
                        else *(f32x4*)(C + (size_t)row * ldc + col) = v; } } }
#undef EPF_LOAD
    }
};
}

struct Args {
    const float* in[23];
    float* out; unsigned char* ws;
    int ph_lo, ph_hi;
};

struct Frame {
    LAS unsigned char* lds;
    int tid, lane, wave, G, bid;
    int vid;
};

__device__ __forceinline__ void transpose_item(const float* src, int ld_src, int nvalid, bf16_t* dst, int ld_dst, int nblk, int item, int lane) {
    const int kb = item / nblk, nb = item % nblk, nq = lane & 15, kg = lane >> 4, k = 32 * kb + 8 * kg, n = 64 * nb + 4 * nq;
    f32x4 v[8];
    const bool ok = n < nvalid;
#pragma unroll
    for (int i = 0; i < 8; ++i) v[i] = ok ? *(const f32x4*)(src + (size_t)(k + i) * ld_src + n) : (f32x4){0.f, 0.f, 0.f, 0.f};
#pragma unroll
    for (int jn = 0; jn < 4; ++jn) { u32x4 o; o.x = pk2(v[0][jn], v[1][jn]); o.y = pk2(v[2][jn], v[3][jn]); o.z = pk2(v[4][jn], v[5][jn]); o.w = pk2(v[6][jn], v[7][jn]);
        *(u32x4*)(dst + (size_t)(n + jn) * ld_dst + k) = o; }
}
template <bool OUT_F32>
__device__ __forceinline__ void rms_row(const float* xrow, const float* gain, void* orow, int lane) {
    const f32x4* xr = (const f32x4*)xrow + lane; const f32x4* gr = (const f32x4*)gain + lane;
    f32x4 v[16]; float s = 0.f;
#pragma unroll
    for (int j = 0; j < 16; ++j) { v[j] = xr[64 * j]; s += (v[j].x * v[j].x + v[j].y * v[j].y) + (v[j].z * v[j].z + v[j].w * v[j].w); }
    const float rstd = 1.f / sqrtf(wave_sum(s) * (1.f / D) + RMS_EPS);
#pragma unroll
    for (int j = 0; j < 16; ++j) { const f32x4 g = gr[64 * j]; const f32x4 o = v[j] * rstd * g;
        if (OUT_F32) ((f32x4*)orow)[lane + 64 * j] = o;
        else ((u32x2*)orow)[lane + 64 * j] = (u32x2){pk2(o.x, o.y), pk2(o.z, o.w)}; }
}
__device__ __forceinline__ void cvt_stream(const float* src, bf16_t* dst, size_t n8, size_t gtid, size_t gthreads) {
    for (size_t i = gtid; i < n8; i += gthreads) { const f32x4 a = ((const f32x4*)src)[2 * i], b = ((const f32x4*)src)[2 * i + 1];
        ((u32x4*)dst)[i] = (u32x4){pk2(a.x, a.y), pk2(a.z, a.w), pk2(b.x, b.y), pk2(b.z, b.w)}; }
}

__device__ __forceinline__ void rms_row_q(const float* xrow, const float* gain, bf16_t* orow, unsigned char* qrow, float* qscale, int lane) {
    const f32x4* xr = (const f32x4*)xrow + lane; const f32x4* gr = (const f32x4*)gain + lane;
    f32x4 v[16]; float s = 0.f;
#pragma unroll
    for (int j = 0; j < 16; ++j) { v[j] = xr[64 * j]; s += (v[j].x * v[j].x + v[j].y * v[j].y) + (v[j].z * v[j].z + v[j].w * v[j].w); }
    const float rstd = 1.f / sqrtf(wave_sum(s) * (1.f / D) + RMS_EPS);
    float amax = 0.f;
#pragma unroll
    for (int j = 0; j < 16; ++j) { const f32x4 g = gr[64 * j]; v[j] = v[j] * rstd * g; ((u32x2*)orow)[lane + 64 * j] = (u32x2){pk2(v[j].x, v[j].y), pk2(v[j].z, v[j].w)};
        amax = fmaxf(fmaxf(amax, fmaxf(fabsf(v[j].x), fabsf(v[j].y))), fmaxf(fabsf(v[j].z), fabsf(v[j].w))); }
    amax = fmaxf(amax, __shfl_xor(amax, 1)); amax = fmaxf(amax, __shfl_xor(amax, 2)); amax = fmaxf(amax, __shfl_xor(amax, 4));
    amax = fmaxf(amax, __shfl_xor(amax, 8)); amax = fmaxf(amax, __shfl_xor(amax, 16)); amax = fmaxf(amax, __shfl_xor(amax, 32));
    const float scale = amax > 0.f ? 127.f / amax : 0.f;
#pragma unroll
    for (int j = 0; j < 16; ++j) { const int ia = (int)__builtin_rintf(v[j].x * scale), ib = (int)__builtin_rintf(v[j].y * scale), ic = (int)__builtin_rintf(v[j].z * scale), id = (int)__builtin_rintf(v[j].w * scale);
        ((unsigned*)qrow)[lane + 64 * j] = ((unsigned)ia & 255u) | (((unsigned)ib & 255u) << 8) | (((unsigned)ic & 255u) << 16) | ((unsigned)id << 24); }
    if (lane == 0) *qscale = amax * (1.f / 127.f);
}

__device__ __forceinline__ unsigned pack_i8x4(float a, float b, float c, float d) {
    const int ia = (int)__builtin_rintf(a), ib = (int)__builtin_rintf(b), ic = (int)__builtin_rintf(c), id = (int)__builtin_rintf(d);
    return ((unsigned)ia & 255u) | (((unsigned)ib & 255u) << 8) | (((unsigned)ic & 255u) << 16) | ((unsigned)id << 24);
}
constexpr int CW_CMAX_IN = 16384, CW_CMAX_PG = 32768, CW_CMAX_OUT = 45056, CW_ROWMAX = 49152, CW_CMAX_PQ = 40960, CW_CMAX_UPP = 57344, CW_CMAX_UPN = 61440, CW_ROWMAX_P = 65536, CW_ROWMAX_N = 73728;
constexpr size_t SB_IN = WS_SMALL + 1048576, SB_PG = SB_IN + 65536, SA_H = SB_PG + 16384, SA_R = SA_H + 32768, SB_OUT = SA_R + 32768, SA_M = SB_OUT + 16384, SB_UPP = SA_M + 32768, SB_UPN = SB_UPP + 16384, SA_P = SB_UPN + 16384, SA_N = SA_P + 32768, SB_PQ = SA_N + 32768;
__device__ __forceinline__ void colmax_item(const float* src, int ld, int ncols, unsigned* cmax, int nblk, int item, int lane) {
    const int kb = item / nblk, nb = item % nblk, n = 256 * nb + 4 * lane;
    if (n >= ncols) return;
    f32x4 m = {0.f, 0.f, 0.f, 0.f};
#pragma unroll 16
    for (int i = 0; i < 64; ++i) { const f32x4 v = *(const f32x4*)(src + (size_t)(64 * kb + i) * ld + n); m.x = fmaxf(m.x, fabsf(v.x)); m.y = fmaxf(m.y, fabsf(v.y)); m.z = fmaxf(m.z, fabsf(v.z)); m.w = fmaxf(m.w, fabsf(v.w)); }
    atomicMax(cmax + n, __float_as_uint(m.x)); atomicMax(cmax + n + 1, __float_as_uint(m.y)); atomicMax(cmax + n + 2, __float_as_uint(m.z)); atomicMax(cmax + n + 3, __float_as_uint(m.w));
}
__device__ __forceinline__ void transpose_item_q(const float* src, int ld_src, int nvalid, unsigned char* dst, int ld_dst, const unsigned* cmax, float* sb, int nblk, int item, int lane) {
    const int kb = item / nblk, nb = item % nblk, nq = lane & 7, kg = lane >> 3, k = 128 * kb + 16 * kg, n = 32 * nb + 4 * nq;
    f32x4 v[16];
    const bool ok = n < nvalid;
#pragma unroll
    for (int i = 0; i < 16; ++i) v[i] = ok ? *(const f32x4*)(src + (size_t)(k + i) * ld_src + n) : (f32x4){0.f, 0.f, 0.f, 0.f};
#pragma unroll
    for (int jn = 0; jn < 4; ++jn) { const float amax = __uint_as_float(cmax[n + jn]), sc = amax > 0.f ? 127.f / amax : 0.f;
        u32x4 o; o.x = pack_i8x4(v[0][jn] * sc, v[1][jn] * sc, v[2][jn] * sc, v[3][jn] * sc); o.y = pack_i8x4(v[4][jn] * sc, v[5][jn] * sc, v[6][jn] * sc, v[7][jn] * sc);
        o.z = pack_i8x4(v[8][jn] * sc, v[9][jn] * sc, v[10][jn] * sc, v[11][jn] * sc); o.w = pack_i8x4(v[12][jn] * sc, v[13][jn] * sc, v[14][jn] * sc, v[15][jn] * sc);
        *(u32x4*)(dst + (size_t)(n + jn) * ld_dst + k) = o;
        if (kb == 0 && kg == 0) sb[n + jn] = amax * (1.f / 127.f); }
}
__device__ __forceinline__ void rms_row_i8(const float* xrow, const float* gain, unsigned char* qrow, float* qscale, int lane) {
    const f32x4* xr = (const f32x4*)xrow + lane; const f32x4* gr = (const f32x4*)gain + lane;
    f32x4 v[16]; float s = 0.f;
#pragma unroll
    for (int j = 0; j < 16; ++j) { v[j] = xr[64 * j]; s += (v[j].x * v[j].x + v[j].y * v[j].y) + (v[j].z * v[j].z + v[j].w * v[j].w); }
    const float rstd = 1.f / sqrtf(wave_sum(s) * (1.f / D) + RMS_EPS);
    float amax = 0.f;
#pragma unroll
    for (int j = 0; j < 16; ++j) { v[j] = v[j] * rstd * gr[64 * j]; amax = fmaxf(fmaxf(amax, fmaxf(fabsf(v[j].x), fabsf(v[j].y))), fmaxf(fabsf(v[j].z), fabsf(v[j].w))); }
#pragma unroll
    for (int o = 1; o < 64; o <<= 1) amax = fmaxf(amax, __shfl_xor(amax, o));
    const float scale = amax > 0.f ? 127.f / amax : 0.f;
#pragma unroll
    for (int j = 0; j < 16; ++j) ((unsigned*)qrow)[lane + 64 * j] = pack_i8x4(v[j].x * scale, v[j].y * scale, v[j].z * scale, v[j].w * scale);
    if (lane == 0) *qscale = amax * (1.f / 127.f);
}
__device__ __forceinline__ void rms_row_i8_b(const bf16_t* xrow, const float* gain, unsigned char* qrow, float* qscale, int lane) {
    const u32x2* xr = (const u32x2*)xrow + lane; const f32x4* gr = (const f32x4*)gain + lane;
    f32x4 v[16]; float s = 0.f;
#pragma unroll
    for (int j = 0; j < 16; ++j) { { const u32x2 q = xr[64 * j]; v[j] = (f32x4){bflo(q.x), bfhi(q.x), bflo(q.y), bfhi(q.y)}; } s += (v[j].x * v[j].x + v[j].y * v[j].y) + (v[j].z * v[j].z + v[j].w * v[j].w); }
    const float rstd = 1.f / sqrtf(wave_sum(s) * (1.f / D) + RMS_EPS);
    float amax = 0.f;
#pragma unroll
    for (int j = 0; j < 16; ++j) { v[j] = v[j] * rstd * gr[64 * j]; amax = fmaxf(fmaxf(amax, fmaxf(fabsf(v[j].x), fabsf(v[j].y))), fmaxf(fabsf(v[j].z), fabsf(v[j].w))); }
#pragma unroll
    for (int o = 1; o < 64; o <<= 1) amax = fmaxf(amax, __shfl_xor(amax, o));
    const float scale = amax > 0.f ? 127.f / amax : 0.f;
#pragma unroll
    for (int j = 0; j < 16; ++j) ((unsigned*)qrow)[lane + 64 * j] = pack_i8x4(v[j].x * scale, v[j].y * scale, v[j].z * scale, v[j].w * scale);
    if (lane == 0) *qscale = amax * (1.f / 127.f);
}

template <int NJ>
__device__ __forceinline__ void requant_rows(const Frame& F, const bf16_t* src, unsigned char* dst, const unsigned* rowmax, float* sa) {
    const int gw = F.bid * NWAVES + F.wave, NGW = F.G * NWAVES, lane = F.lane; constexpr int ncols = NJ * 512;
    for (int m0 = gw; m0 < T; m0 += 4 * NGW) { u32x4 q[4][NJ]; float am[4];
#pragma unroll
        for (int r = 0; r < 4; ++r) { const int m = (m0 + r * NGW < T) ? m0 + r * NGW : m0; am[r] = __uint_as_float(rowmax[m]); const u32x4* sp = (const u32x4*)(src + (size_t)m * ncols) + lane;
#pragma unroll
            for (int j = 0; j < NJ; ++j) q[r][j] = sp[64 * j]; }
#pragma unroll
        for (int r = 0; r < 4; ++r) { const int m = m0 + r * NGW;
            if (m < T) { const float sc = am[r] > 0.f ? 127.f / am[r] : 0.f; u32x2* dp = (u32x2*)(dst + (size_t)m * ncols) + lane;
#pragma unroll
                for (int j = 0; j < NJ; ++j) { const u32x4 qq = q[r][j];
                    dp[64 * j] = (u32x2){pack_i8x4(bflo(qq.x) * sc, bfhi(qq.x) * sc, bflo(qq.y) * sc, bfhi(qq.y) * sc), pack_i8x4(bflo(qq.z) * sc, bfhi(qq.z) * sc, bflo(qq.w) * sc, bfhi(qq.w) * sc)}; }
                if (lane == 0) sa[m] = am[r] * (1.f / 127.f); } } }
}

typedef __fp16 h16x2 __attribute__((ext_vector_type(2)));
template <int NCH>
__device__ __forceinline__ void quant_colblock(const Frame& F, const float* src, int ld_src, int nvalid, unsigned char* dst, int ld_dst, float* sb) {
    const int lane = F.lane, w = F.wave, nq = lane & 7, kg = lane >> 3, n = 4 * nq; constexpr int rows = NCH * 128, NREG = NCH < 2 ? NCH : 2;
    const bool ok = n < nvalid;
    LAS float* cm = (LAS float*)F.lds;
    LAS u32x4* hl = (LAS u32x4*)(F.lds + 4096) + F.tid;
    f32x4 m = {0.f, 0.f, 0.f, 0.f};
    unsigned h[NREG][16][2];
    const float* rb = src + (size_t)(w * rows) * ld_src;
    const unsigned loff = (unsigned)(16 * kg) * (unsigned)ld_src + (unsigned)n;
    f32x4 vb[2][8];
#pragma unroll
    for (int bt = 0; bt <= 2 * NCH; ++bt) {
        if (bt < 2 * NCH) {
#pragma unroll
            for (int i = 0; i < 8; ++i) vb[bt & 1][i] = *(const f32x4*)(rb + (size_t)((bt >> 1) * 128 + 8 * (bt & 1) + i) * ld_src + loff); }
        __builtin_amdgcn_sched_barrier(0);
        if (bt > 0) { const int pb = bt - 1, c = pb >> 1, hb = pb & 1; f32x4 (&v)[8] = vb[pb & 1]; unsigned t[8][2];
#pragma unroll
            for (int i = 0; i < 8; ++i) { v[i].x = ok ? v[i].x : 0.f; v[i].y = ok ? v[i].y : 0.f; v[i].z = ok ? v[i].z : 0.f; v[i].w = ok ? v[i].w : 0.f; }
#pragma unroll
            for (int i = 0; i < 8; ++i) { m.x = fmaxf(m.x, fabsf(v[i].x)); m.y = fmaxf(m.y, fabsf(v[i].y)); m.z = fmaxf(m.z, fabsf(v[i].z)); m.w = fmaxf(m.w, fabsf(v[i].w));
                t[i][0] = __builtin_bit_cast(unsigned, __builtin_amdgcn_cvt_pkrtz(v[i].x, v[i].y)); t[i][1] = __builtin_bit_cast(unsigned, __builtin_amdgcn_cvt_pkrtz(v[i].z, v[i].w)); }
            if (c < NREG) {
#pragma unroll
                for (int i = 0; i < 8; ++i) { h[c < NREG ? c : 0][8 * hb + i][0] = t[i][0]; h[c < NREG ? c : 0][8 * hb + i][1] = t[i][1]; } }
            else {
#pragma unroll
                for (int e = 0; e < 4; ++e) hl[((c - 2) * 8 + 4 * hb + e) * 512] = (u32x4){t[2 * e][0], t[2 * e][1], t[2 * e + 1][0], t[2 * e + 1][1]}; }
            __builtin_amdgcn_sched_barrier(0); } }
#pragma unroll
    for (int sh = 8; sh < 64; sh <<= 1) { m.x = fmaxf(m.x, __shfl_xor(m.x, sh)); m.y = fmaxf(m.y, __shfl_xor(m.y, sh)); m.z = fmaxf(m.z, __shfl_xor(m.z, sh)); m.w = fmaxf(m.w, __shfl_xor(m.w, sh)); }
    if (kg == 0) *(LAS f32x4*)(cm + w * 32 + n) = m;
    __syncthreads();
    f32x4 am = *(const LAS f32x4*)(cm + n);
#pragma unroll
    for (int ww = 1; ww < 8; ++ww) { const f32x4 t = *(const LAS f32x4*)(cm + ww * 32 + n); am.x = fmaxf(am.x, t.x); am.y = fmaxf(am.y, t.y); am.z = fmaxf(am.z, t.z); am.w = fmaxf(am.w, t.w); }
    f32x4 sc; sc.x = am.x > 0.f ? 127.f / am.x : 0.f; sc.y = am.y > 0.f ? 127.f / am.y : 0.f; sc.z = am.z > 0.f ? 127.f / am.z : 0.f; sc.w = am.w > 0.f ? 127.f / am.w : 0.f;
    if (w == 0 && kg == 0) *(f32x4*)(sb + n) = am * (1.f / 127.f);
    unsigned char* db = dst + w * rows;
    const unsigned doff = (unsigned)n * (unsigned)ld_dst + (unsigned)(16 * kg);
#pragma unroll
    for (int c = 0; c < NCH; ++c) { unsigned t[16][2];
        if (c < NREG) {
#pragma unroll
            for (int i = 0; i < 16; ++i) { t[i][0] = h[c < NREG ? c : 0][i][0]; t[i][1] = h[c < NREG ? c : 0][i][1]; } }
        else {
#pragma unroll
            for (int e = 0; e < 8; ++e) { const u32x4 q = hl[((c - 2) * 8 + e) * 512]; t[2 * e][0] = q.x; t[2 * e][1] = q.y; t[2 * e + 1][0] = q.z; t[2 * e + 1][1] = q.w; } }
#pragma unroll
        for (int jn = 0; jn < 4; ++jn) { const float s1 = sc[jn];
#define HV(i) ((float)__builtin_bit_cast(h16x2, t[i][jn >> 1])[jn & 1] * s1)
            u32x4 o; o.x = pack_i8x4(HV(0), HV(1), HV(2), HV(3)); o.y = pack_i8x4(HV(4), HV(5), HV(6), HV(7)); o.z = pack_i8x4(HV(8), HV(9), HV(10), HV(11)); o.w = pack_i8x4(HV(12), HV(13), HV(14), HV(15));
#undef HV
            *(u32x4*)(db + (size_t)(jn * ld_dst + c * 128) + doff) = o; }
        __builtin_amdgcn_sched_barrier(0); }
    __syncthreads();
}
__device__ __forceinline__ void phase_prologue(const Frame& F, const Args& a) {
    unsigned char* ws = a.ws;
    const int gw = F.bid * NWAVES + F.wave, NGW = F.G * NWAVES;
    const float* w_in = a.in[3];
    unsigned char* W8 = ws + WS_W_IN; float* sb_in = (float*)(ws + SB_IN);
    constexpr int B0 = 232, B1 = B0 + 256, B2 = B1 + 128, B3 = B2 + 128, NBIG = B3 + 64, NSMALL = 256;
    for (int bb = F.bid; bb < NBIG; bb += F.G) { const float* src; int ld, nv = 32; unsigned char* dst; float* sb;
        if (bb < B0) { src = w_in + 32 * bb; ld = IN_W; nv = 7216 - 32 * bb; dst = W8 + (size_t)32 * bb * D; sb = sb_in + 32 * bb; }
        else if (bb < B1) { const int b = bb - B0; src = w_in + 7216 + 32 * b; ld = IN_W; dst = W8 + (size_t)(7424 + 32 * b) * D; sb = sb_in + 7424 + 32 * b; }
        else if (bb < B2) { const int b = bb - B1; src = a.in[20] + 32 * b; ld = D; dst = ws + WS_W_PG + (size_t)32 * b * D; sb = (float*)(ws + SB_PG) + 32 * b; }
        else if (bb < B3) { const int b = bb - B2; src = a.in[12] + 32 * b; ld = D; dst = ws + WS_W_OUT + (size_t)32 * b * D; sb = (float*)(ws + SB_OUT) + 32 * b; }
        else { const int b = bb - B3; src = a.in[14] + 32 * b; ld = 2048; dst = ws + WS_W_PQ + (size_t)32 * b * D; sb = (float*)(ws + SB_PQ) + 32 * b; }
        quant_colblock<4>(F, src, ld, nv, dst, D, sb); }
    { const int rem = NBIG % F.G, span = (F.G > rem) ? F.G - rem : F.G, first = (F.G > rem) ? F.bid - rem : F.bid;
      if (first >= 0) for (int sblk = first; sblk < NSMALL; sblk += span) { const int b = sblk & 127, hi = sblk >> 7;
          quant_colblock<2>(F, a.in[10 + hi] + 32 * b, D, 32, ws + (hi ? WS_W_UPN : WS_W_UPP) + (size_t)32 * b * 2048, 2048, (float*)(ws + (hi ? SB_UPN : SB_UPP)) + 32 * b); } }
    { constexpr int J0 = 8 * 64, J1 = J0 + 4 * 128, J2 = J1 + 4 * 128;
      for (int it = gw; it < J2; it += NGW) {
          if (it < J0) transpose_item(a.in[21], D, D, (bf16_t*)(ws + WS_W_PP), 256, 64, it, F.lane);
          else if (it < J1) { const int gi = (it - J0) >> 7; transpose_item(a.in[4] + (size_t)gi * 512 * 512, 512, 512, (bf16_t*)(ws + WS_W_POOL) + (size_t)gi * 512 * 512, 512, 8, (it - J0) & 127, F.lane); }
          else { const int j = (it - J1) >> 7, kv = j >> 1, half = j & 1;
              transpose_item(a.in[8 + kv] + (size_t)half * 2048 * 128, 128, 128, (bf16_t*)(ws + WS_W_CMP) + (size_t)(kv * 256 + half * 128) * 2048, 2048, 2, (it - J1) & 127, F.lane); } } }
    const size_t gtid = (size_t)F.bid * NTHREADS + F.tid, gth = (size_t)F.G * NTHREADS;
    cvt_stream(a.in[1], (bf16_t*)(ws + WS_PBF), (size_t)T * 256 / 8, gtid, gth);
    cvt_stream(a.in[15], (bf16_t*)(ws + WS_SMALL + 4096), 128 * 128 / 8, gtid, gth);
    cvt_stream(a.in[16], (bf16_t*)(ws + WS_SMALL + 4096 + 32768), 128 * 128 / 8, gtid, gth);
    if (gw < 64) { const int kv = gw >> 5, w = gw & 31; const float* pos = a.in[6 + kv]; const float* W = a.in[8 + kv]; float s0 = 0.f, s1 = 0.f;
        for (int i0 = w * 128; i0 < w * 128 + 128; i0 += 16) { float pv[16], w0[16], w1[16];
#pragma unroll
            for (int j = 0; j < 16; ++j) { pv[j] = pos[i0 + j]; w0[j] = W[(size_t)(i0 + j) * 128 + F.lane]; w1[j] = W[(size_t)(i0 + j) * 128 + 64 + F.lane]; }
#pragma unroll
            for (int j = 0; j < 16; ++j) { s0 = fmaf(pv[j], w0[j], s0); s1 = fmaf(pv[j], w1[j], s1); } }
        float* part = (float*)(ws + WS_SMALL + 131072) + (size_t)gw * 128; part[F.lane] = s0; part[64 + F.lane] = s1; }
    { unsigned* ctr = (unsigned*)(ws + WS_CTL) + 3072; LAS unsigned* slot = (LAS unsigned*)(F.lds + 2048);
      for (;;) { if (F.tid == 0) *slot = xb_add(ctr, 1u);
          __syncthreads(); const int m0 = (int)*slot * 32; __syncthreads();
          if (m0 >= T) break;
          for (int j = 0; j < 4; ++j) { const int m = m0 + 4 * F.wave + j; rms_row_i8(a.in[0] + (size_t)m * D, a.in[2], ws + WS_A + (size_t)m * D, (float*)(ws + SA_H) + m, F.lane); } } }
}

__device__ __forceinline__ void phase_pool_prep(const Frame& F, const Args& a) {
    unsigned char* ws = a.ws;
    const bf16_t* Z = (const bf16_t*)(ws + WS_R1);
    bf16_t* pooled = (bf16_t*)(ws + WS_A);
    const size_t gtid = (size_t)F.bid * NTHREADS + F.tid, gth = (size_t)F.G * NTHREADS;
    if (gtid < 256) { const int kv = (int)(gtid >> 7), c = (int)(gtid & 127); const float* part = (const float*)(ws + WS_SMALL + 131072) + (size_t)kv * 32 * 128 + c; float sb = 0.f;
        for (int w = 0; w < 32; ++w) sb += part[w * 128];
        ((float*)(ws + WS_SMALL))[gtid] = sb; }
    for (size_t i = gtid; i < (size_t)T * 256; i += gth) {
        const int t = (int)(i >> 8), c8 = (int)(i & 255), gi = c8 >> 6;
        const bf16_t* zp = Z + (size_t)t * ZW + ZC_POOL + c8 * 8;
        float s[8] = {0, 0, 0, 0, 0, 0, 0, 0}; u32x4 own = *(const u32x4*)zp; int cnt = 1;
#define POOL_WIN(W) do { u32x4 q[W]; _Pragma("unroll") for (int k = 0; k < W; ++k) q[k] = (k == 0) ? own : ((t - k >= 0) ? *(const u32x4*)(zp - (size_t)k * ZW) : (u32x4){0u, 0u, 0u, 0u}); \
            _Pragma("unroll") for (int k = 0; k < W; ++k) { s[0] += bflo(q[k].x); s[1] += bfhi(q[k].x); s[2] += bflo(q[k].y); s[3] += bfhi(q[k].y); s[4] += bflo(q[k].z); s[5] += bfhi(q[k].z); s[6] += bflo(q[k].w); s[7] += bfhi(q[k].w); } \
            cnt = (t + 1 < W) ? (t + 1) : W; } while (0)
        if (gi == 0) POOL_WIN(2); else if (gi == 1) POOL_WIN(4); else if (gi == 2) POOL_WIN(8); else POOL_WIN(16);
#undef POOL_WIN
        const float inv = 1.f / (float)cnt;
        u32x4 o; o.x = pk2(s[0] * inv - bflo(own.x), s[1] * inv - bfhi(own.x)); o.y = pk2(s[2] * inv - bflo(own.y), s[3] * inv - bfhi(own.y));
        o.z = pk2(s[4] * inv - bflo(own.z), s[5] * inv - bfhi(own.z)); o.w = pk2(s[6] * inv - bflo(own.w), s[7] * inv - bfhi(own.w));
        *(u32x4*)(pooled + (size_t)t * 2048 + c8 * 8) = o;
    }
    bf16_t* acmp = (bf16_t*)(ws + WS_ACMP);
    for (size_t i = gtid; i < (size_t)4096 * 256; i += gth) {
        const int row = (int)(i >> 8), ch = (int)(i & 255), kvg = row >> 9, j = row & 511, l = ch >> 4, d8 = ch & 15;
        *(u32x4*)(acmp + (size_t)row * 2048 + ch * 8) = *(const u32x4*)(Z + (size_t)(16 * j + l) * ZW + ZC_KV + kvg * 128 + d8 * 8);
    }
}


__device__ __forceinline__ void pool_window_rows(const Frame& F, const bf16_t* Y, unsigned char* dst, float* sa) {
    const int gw = F.bid * NWAVES + F.wave, NGW = F.G * NWAVES, lane = F.lane;
    for (int t = 2 * gw; t < T; t += 2 * NGW) {
        float oA[4][8], oB[4][8]; float amA = 0.f, amB = 0.f;
#define PW_E(q, i) (((i) & 1) ? bfhi(((i) >> 1) == 0 ? (q).x : ((i) >> 1) == 1 ? (q).y : ((i) >> 1) == 2 ? (q).z : (q).w) : bflo(((i) >> 1) == 0 ? (q).x : ((i) >> 1) == 1 ? (q).y : ((i) >> 1) == 2 ? (q).z : (q).w))
#define PW_GROUP(gi, W) do { const bf16_t* yp = Y + (size_t)(t + 1) * 2048 + (gi) * 512 + lane * 8; u32x4 q[W + 1]; \
            _Pragma("unroll") for (int k = 0; k <= W; ++k) q[k] = (t + 1 - k >= 0) ? *(const u32x4*)(yp - (size_t)k * 2048) : (u32x4){0u, 0u, 0u, 0u}; \
            float S[8] = {0, 0, 0, 0, 0, 0, 0, 0}; \
            _Pragma("unroll") for (int k = 1; k < W; ++k) { _Pragma("unroll") for (int i = 0; i < 8; ++i) S[i] += PW_E(q[k], i); } \
            const float invA = 1.f / (float)((t + 2 < W) ? (t + 2) : W), invB = 1.f / (float)((t + 1 < W) ? (t + 1) : W); \
            _Pragma("unroll") for (int i = 0; i < 8; ++i) { const float a0 = PW_E(q[0], i), a1 = PW_E(q[1], i), aW = PW_E(q[W], i); \
                oA[gi][i] = (S[i] + a0) * invA - a0; oB[gi][i] = (S[i] + aW) * invB - a1; amA = fmaxf(amA, fabsf(oA[gi][i])); amB = fmaxf(amB, fabsf(oB[gi][i])); } } while (0)
        PW_GROUP(0, 2); PW_GROUP(1, 4); PW_GROUP(2, 8); PW_GROUP(3, 16);
#undef PW_GROUP
#undef PW_E
#pragma unroll
        for (int sh = 1; sh < 64; sh <<= 1) { amA = fmaxf(amA, __shfl_xor(amA, sh)); amB = fmaxf(amB, __shfl_xor(amB, sh)); }
        const float scA = amA > 0.f ? 127.f / amA : 0.f, scB = amB > 0.f ? 127.f / amB : 0.f;
#pragma unroll
        for (int gi = 0; gi < 4; ++gi) {
            ((u32x2*)(dst + (size_t)t * 2048 + gi * 512))[lane] =
                (u32x2){pack_i8x4(oB[gi][0] * scB, oB[gi][1] * scB, oB[gi][2] * scB, oB[gi][3] * scB), pack_i8x4(oB[gi][4] * scB, oB[gi][5] * scB, oB[gi][6] * scB, oB[gi][7] * scB)};
            ((u32x2*)(dst + (size_t)(t + 1) * 2048 + gi * 512))[lane] =
                (u32x2){pack_i8x4(oA[gi][0] * scA, oA[gi][1] * scA, oA[gi][2] * scA, oA[gi][3] * scA), pack_i8x4(oA[gi][4] * scA, oA[gi][5] * scA, oA[gi][6] * scA, oA[gi][7] * scA)}; }
        if (lane == 0) { sa[t] = amB * (1.f / 127.f); sa[t + 1] = amA * (1.f / 127.f); }
    }
}

__device__ __forceinline__ void phase_cmp_combine(const Frame& F, const Args& a) {
    unsigned char* ws = a.ws; const float* H = (const float*)(ws + WS_HCMP); const float* bias = (const float*)(ws + WS_SMALL); bf16_t* kcvc = (bf16_t*)(ws + WS_KCVC);
    const size_t gtid = (size_t)F.bid * NTHREADS + F.tid, gth = (size_t)F.G * NTHREADS;
    for (size_t i0 = gtid; i0 < (size_t)2 * 4 * 512 * 128; i0 += 4 * gth) { float v[4];
#pragma unroll
        for (int j = 0; j < 4; ++j) { const size_t i = i0 + (size_t)j * gth; v[j] = 0.f;
            if (i < (size_t)2 * 4 * 512 * 128) { const int c = (int)(i & 127), n = (int)((i >> 7) & 511), g = (int)((i >> 16) & 3), kv = (int)(i >> 18);
                if (n <= 510) { const size_t r = (size_t)kv * 2048 + g * 512 + n; v[j] = H[r * 512 + kv * 256 + c] + H[(r + 1) * 512 + kv * 256 + 128 + c] + bias[kv * 128 + c]; } } }
#pragma unroll
        for (int j = 0; j < 4; ++j) { const size_t i = i0 + (size_t)j * gth; if (i < (size_t)2 * 4 * 512 * 128) kcvc[i] = (bf16_t)f2bf(v[j]); }
    }
}

namespace at {
constexpr int SHM = 16384;
constexpr int L_V = 0, L_K = 3 * SHM, L_WS = 6 * SHM, L_IMP = L_WS + 2048, IMP_LD = 132, L_SEL = L_IMP + 64 * IMP_LD * 4, L_UNI = L_SEL + 1024, L_CNT = L_UNI + 16,
              L_LC = L_CNT + 16, L_LW = L_LC + 64, L_LS = L_LW + 64, L_END = L_LS + 132 * 4;
static_assert(L_END <= MISC_OFF, "attention LDS map");
constexpr float LOG2E = 1.4426950408889634f;
constexpr float CS = 0.088388347648318440f * 1.4426950408889634f;
#define KSWZ(row, colB) ((row) * 256 + ((colB) ^ (((row) & 7) << 4)))
#define SBAR() __builtin_amdgcn_sched_barrier(0)
__device__ __forceinline__ int crow(int r, int hi) { return (r & 3) + 8 * (r >> 2) + 4 * hi; }
__device__ __forceinline__ int v_st(int k, int c) { const int kk = (k & ~0xC) | ((k & 4) << 1) | ((k & 8) >> 1); return ((kk >> 3) * 4 + (c >> 5)) * 512 + ((kk & 7) * 32 + (c & 31)) * 2; }
__device__ __forceinline__ int v_rd_base(int lane) { return ((lane & 3) << 3) | (((lane >> 2) & 3) << 6) | (((lane >> 4) & 1) << 5) | (((lane >> 5) & 1) << 8); }
constexpr int v_rd_off(int d0, int ks, int half) { return d0 * 512 + ks * 4096 + half * 2048; }
template <int OFF> __device__ __forceinline__ s16x4 tr_read(int vb) { s16x4 r; asm volatile("ds_read_b64_tr_b16 %0, %1 offset:%2" : "=&v"(r) : "v"(vb), "i"(OFF) : "memory"); return r; }

__device__ __forceinline__ void qkt(f32x16& p0, f32x16& p1, const LAS char* Ks, const bf16x8 (&qr)[8], int r32, int hi) {
    p0 = f32x16{}; p1 = f32x16{};
#pragma unroll
    for (int d0 = 0; d0 < 8; ++d0) { const int cb = (d0 * 16 + hi * 8) * 2;
        const bf16x8 b0 = *(const LAS bf16x8*)(Ks + KSWZ(r32, cb));
        const bf16x8 b1 = *(const LAS bf16x8*)(Ks + KSWZ(32 + r32, cb));
        p0 = __builtin_amdgcn_mfma_f32_32x32x16_bf16(b0, qr[d0], p0, 0, 0, 0);
        p1 = __builtin_amdgcn_mfma_f32_32x32x16_bf16(b1, qr[d0], p1, 0, 0, 0);
        if (d0 == 3) SBAR(); }
}
template <int D0> __device__ __forceinline__ void pv_one(f32x16& od, int vb, bf16x8 pa0, bf16x8 pa1, bf16x8 pa2, bf16x8 pa3) {
    const s16x4 l0 = tr_read<v_rd_off(D0, 0, 0)>(vb), h0 = tr_read<v_rd_off(D0, 0, 1)>(vb), l1 = tr_read<v_rd_off(D0, 1, 0)>(vb), h1 = tr_read<v_rd_off(D0, 1, 1)>(vb);
    const s16x4 l2 = tr_read<v_rd_off(D0, 2, 0)>(vb), h2 = tr_read<v_rd_off(D0, 2, 1)>(vb), l3 = tr_read<v_rd_off(D0, 3, 0)>(vb), h3 = tr_read<v_rd_off(D0, 3, 1)>(vb);
    asm volatile("s_waitcnt lgkmcnt(0)" ::: "memory"); SBAR();
#define PK(L, H) (bf16x8){L[0], L[1], L[2], L[3], H[0], H[1], H[2], H[3]}
    od = __builtin_amdgcn_mfma_f32_32x32x16_bf16(pa0, PK(l0, h0), od, 0, 0, 0);
    od = __builtin_amdgcn_mfma_f32_32x32x16_bf16(pa1, PK(l1, h1), od, 0, 0, 0);
    od = __builtin_amdgcn_mfma_f32_32x32x16_bf16(pa2, PK(l2, h2), od, 0, 0, 0);
    od = __builtin_amdgcn_mfma_f32_32x32x16_bf16(pa3, PK(l3, h3), od, 0, 0, 0);
#undef PK
}
template <int MODE>
__device__ __forceinline__ void bias_mask(f32x16& p0, f32x16& p1, int b, int t, int hi, float slope2, bool selbit) {
    const float base = (MODE == 0) ? (float)(t - 31 - 1024 * b - 64 * hi) : (float)(t - 64 * b - 4 * hi);
    const float nb = -slope2 * base;
#pragma unroll
    for (int r = 0; r < 16; ++r) {
        const int c0 = (r & 3) + 8 * (r >> 2), c1 = 32 + c0;
        const float k0 = (MODE == 0) ? 16.f * c0 : (float)c0, k1 = (MODE == 0) ? 16.f * c1 : (float)c1;
        const float d0 = base - k0, d1 = base - k1;
        bool v0 = d0 >= 0.f, v1 = d1 >= 0.f;
        if (MODE == 1) { v0 = v0 && selbit; v1 = v1 && selbit; }
        if (MODE == 2) { v0 = v0 && (d0 < 512.f); v1 = v1 && (d1 < 512.f); }
        const float s0 = p0[r] + fmaf(slope2, k0, nb), s1 = p1[r] + fmaf(slope2, k1, nb);
        p0[r] = v0 ? s0 : -__builtin_inff(); p1[r] = v1 ? s1 : -__builtin_inff();
    }
}
__device__ __forceinline__ float swap_max(float v) { auto rr = __builtin_amdgcn_permlane32_swap(__float_as_uint(v), __float_as_uint(v), false, false); return fmaxf(__uint_as_float(rr[0]), __uint_as_float(rr[1])); }
__device__ __forceinline__ float swap_sum(float v) { auto rr = __builtin_amdgcn_permlane32_swap(__float_as_uint(v), __float_as_uint(v), false, false); return __uint_as_float(rr[0]) + __uint_as_float(rr[1]); }

__device__ __forceinline__ void dma_offsets(int ldk, int wid, int lane, int (&offK)[2], int (&offV)[2]) {
#pragma unroll
    for (int i = 0; i < 2; ++i) { const int blk = 2 * wid + i;
        { const int row = 4 * blk + (lane >> 4), cp = lane & 15, sc = cp ^ (row & 7); offK[i] = row * ldk + sc * 8; }
        { const int o = blk * 1024 + lane * 16, sub = o >> 9, kk = ((sub >> 2) << 3) | ((o >> 6) & 7), k = (kk & ~0xC) | ((kk & 4) << 1) | ((kk & 8) >> 1), cc = ((sub & 3) << 2) | ((o >> 4) & 3);
          offV[i] = k * ldk + cc * 8; } }
}
__device__ __forceinline__ void dma_tile(LAS char* dst, const bf16_t* src, size_t rowbase, const int (&off)[2], int wid) {
#pragma unroll
    for (int i = 0; i < 2; ++i) __builtin_amdgcn_global_load_lds((const unsigned*)(src + rowbase + off[i]), (LAS unsigned*)(dst + (2 * wid + i) * 1024), 16, 0, 0);
}
constexpr float RESC_THR = 8.f;

template <int MODE>
__device__ __forceinline__ void flash(LAS char* lds, const bf16_t* Kb, const bf16_t* Vb, int ldk, const LAS int* list, int n, const bf16x8 (&qr)[8],
                                      f32x16 (&o)[4], float& m_reg, float& l_reg, int t, float slope2, const LAS unsigned* selw,
                                      int bA, int bB, int tid, int wid, int lane) {
    const int r32 = lane & 31, hi = lane >> 5;
    LAS char* V_lds = lds + L_V; LAS char* K_lds = lds + L_K;
    LAS float* al_l = (LAS float*)(lds + L_WS) + wid * 64 + 32;
    const int vb0 = (int)(unsigned)(size_t)V_lds + v_rd_base(lane);
#pragma unroll
    for (int d = 0; d < 4; ++d) o[d] = f32x16{};
    m_reg = -1e30f; l_reg = 0.f;
    if (n <= 0) return;
    const float ks = (MODE == 0) ? 16.f : 1.f;
    const int half = wid >> 2;
#define BAR() do { asm volatile("" ::: "memory"); __builtin_amdgcn_s_barrier(); asm volatile("" ::: "memory"); } while (0)
#define DMA(ti, slot) do { const int _b = __builtin_amdgcn_readfirstlane(list[ti]); int offK[2], offV[2]; dma_offsets(ldk, wid, lane, offK, offV); \
        dma_tile(K_lds + (slot) * SHM, Kb, (size_t)_b * 64 * ldk, offK, wid); dma_tile(V_lds + (slot) * SHM, Vb, (size_t)_b * 64 * ldk, offV, wid); } while (0)
#define PV(slot) do { const int _vb = vb0 + (slot) * SHM; pv_one<0>(o[0], _vb, pa0, pa1, pa2, pa3); pv_one<1>(o[1], _vb, pa0, pa1, pa2, pa3); \
        pv_one<2>(o[2], _vb, pa0, pa1, pa2, pa3); pv_one<3>(o[3], _vb, pa0, pa1, pa2, pa3); } while (0)
    DMA(0, 0); if (n > 1) DMA(1, 1); if (n > 2) DMA(2, 2);
    VM_WAIT(); __syncthreads();
    if (half) BAR();
    bf16x8 pa0, pa1, pa2, pa3;
    int buf = 0;
    for (int i = 0; i < n; ++i) {
        const int bcur = __builtin_amdgcn_readfirstlane(list[i]);
        const int pslot = (buf == 0) ? 2 : buf - 1;
        const int nslot = (buf == 2) ? 0 : buf + 1;
        if (half == 0 && i + 1 >= 3 && i + 1 < n) DMA(i + 1, nslot);
        if (i > 0) PV(pslot);
        f32x16 p0, p1;
        qkt(p0, p1, K_lds + buf * SHM, qr, r32, hi);
        if (half == 1) VM_WAIT();
        BAR();
        if (half == 1 && i + 2 >= 3 && i + 2 < n) DMA(i + 2, pslot);
        const int dist0 = (MODE == 0) ? (t - 31 - 1024 * bcur - 64 * hi) : (t - 64 * bcur - 4 * hi);
        float nbl = -slope2 * (float)dist0;
        if (MODE == 1) { const unsigned mw = selw[bcur >> 5]; if (!((mw >> (bcur & 31)) & 1u)) nbl = -__builtin_inff(); }
#pragma unroll
        for (int r = 0; r < 16; ++r) { const float c0 = ks * (float)((r & 3) + 8 * (r >> 2)), c1 = c0 + 32.f * ks; p0[r] = fmaf(slope2, c0, p0[r]); p1[r] = fmaf(slope2, c1, p1[r]); }
        if (bcur >= bA || bcur == bB) {
            const float base = (float)dist0;
#pragma unroll
            for (int r = 0; r < 16; ++r) { const float c0 = ks * (float)((r & 3) + 8 * (r >> 2)), c1 = c0 + 32.f * ks; const float d0 = base - c0, d1 = base - c1;
                bool v0 = d0 >= 0.f, v1 = d1 >= 0.f;
                if (MODE == 2) { v0 = v0 && (d0 < 512.f); v1 = v1 && (d1 < 512.f); }
                p0[r] = v0 ? p0[r] : -__builtin_inff(); p1[r] = v1 ? p1[r] : -__builtin_inff(); }
        }
        float pmax = p0[0], pmax1 = p1[0];
#pragma unroll
        for (int r = 1; r < 16; ++r) { pmax = fmaxf(pmax, p0[r]); pmax1 = fmaxf(pmax1, p1[r]); }
        pmax = swap_max(fmaxf(pmax, pmax1) + nbl);
        if (!__all(pmax - m_reg <= RESC_THR)) {
            const float mn = fmaxf(m_reg, pmax), alpha = __builtin_amdgcn_exp2f(m_reg - mn);
            m_reg = mn; l_reg *= alpha;
            if (hi == 0) al_l[r32] = alpha; LDS_WAIT();
#pragma unroll
            for (int r = 0; r < 16; ++r) { const float a = al_l[crow(r, hi)];
#pragma unroll
                for (int d = 0; d < 4; ++d) o[d][r] *= a; }
        }
        const float nm = nbl - m_reg;
        float ps = 0.f;
#pragma unroll
        for (int r = 0; r < 16; ++r) { p0[r] = __builtin_amdgcn_exp2f(p0[r] + nm); ps += p0[r]; }
#pragma unroll
        for (int r = 0; r < 16; ++r) { p1[r] = __builtin_amdgcn_exp2f(p1[r] + nm); ps += p1[r]; }
        l_reg += swap_sum(ps);
#define PK4(P, BASE, OUT) do { unsigned a0 = cvtpk(P[BASE + 0], P[BASE + 1]), a1 = cvtpk(P[BASE + 2], P[BASE + 3]); \
        unsigned b0 = cvtpk(P[BASE + 4], P[BASE + 5]), b1 = cvtpk(P[BASE + 6], P[BASE + 7]); \
        auto r0 = __builtin_amdgcn_permlane32_swap(a0, b0, false, false); auto r1 = __builtin_amdgcn_permlane32_swap(a1, b1, false, false); \
        u32x4 w = {r0[0], r1[0], r0[1], r1[1]}; OUT = *reinterpret_cast<bf16x8*>(&w); } while (0)
        PK4(p0, 0, pa0); PK4(p0, 8, pa1); PK4(p1, 0, pa2); PK4(p1, 8, pa3);
#undef PK4
        if (half == 0) VM_WAIT();
        BAR();
        buf = nslot;
    }
    { const int pslot = (buf == 0) ? 2 : buf - 1; PV(pslot); }
    BAR();
    if (half == 0) BAR();
#undef PV
#undef DMA
#undef BAR
}

template <int BR>
__device__ __forceinline__ void accum_branch(float* acc_g, bf16_t* out_g, const f32x16 (&o)[4], float fac, LAS float* li_l, int r32, int hi, unsigned* rmax = nullptr) {
    if (hi == 0) li_l[r32] = fac;
    LDS_WAIT();
    float ld[2][4][4];
    if (BR > 0) {
#pragma unroll
        for (int rq = 0; rq < 4; ++rq)
#pragma unroll
            for (int d = 0; d < 4; ++d) ld[0][rq][d] = (acc_g + (size_t)(4 * hi) * 2048 + r32)[rq * 128 + 32 * d]; }
#pragma unroll
    for (int rr = 0; rr < 4; ++rr) {
        float* ab = acc_g + (size_t)(rr + 4 * hi) * 2048 + r32; bf16_t* ob = out_g + (size_t)(rr + 4 * hi) * 2048 + r32;
        if (BR > 0 && rr < 3) {
#pragma unroll
            for (int rq = 0; rq < 4; ++rq)
#pragma unroll
                for (int d = 0; d < 4; ++d) ld[(rr + 1) & 1][rq][d] = (ab + 2048)[rq * 128 + 32 * d]; }
        __builtin_amdgcn_sched_barrier(0);
        float v[4][4];
#pragma unroll
        for (int rq = 0; rq < 4; ++rq) { const float f = li_l[rr + 8 * rq + 4 * hi];
#pragma unroll
            for (int d = 0; d < 4; ++d) { v[rq][d] = o[d][4 * rq + rr] * f; if (BR > 0) v[rq][d] += ld[rr & 1][rq][d]; } }
        float amx = 0.f;
#pragma unroll
        for (int rq = 0; rq < 4; ++rq)
#pragma unroll
            for (int d = 0; d < 4; ++d) { if (BR < 2) ab[rq * 128 + 32 * d] = v[rq][d]; else { const unsigned hb = f2bf(v[rq][d]); ob[rq * 128 + 32 * d] = (bf16_t)hb; amx = fmaxf(amx, fabsf(bflo(hb))); } }
        if (BR == 2) {
            amx = fmaxf(amx, __shfl_xor(amx, 1)); amx = fmaxf(amx, __shfl_xor(amx, 2)); amx = fmaxf(amx, __shfl_xor(amx, 4)); amx = fmaxf(amx, __shfl_xor(amx, 8)); amx = fmaxf(amx, __shfl_xor(amx, 16));
            if (r32 == 0) atomicMax(rmax + rr + 4 * hi, __float_as_uint(amx)); }
        __builtin_amdgcn_sched_barrier(0);
    }
    LDS_WAIT();
}

__device__ __forceinline__ void attn_unit(const Frame& F, unsigned char* ws, int g, int qt) {
    LAS char* lds = (LAS char*)F.lds;
    const int tid = F.tid, wid = F.wave, lane = F.lane, r32 = lane & 31, hi = lane >> 5;
    const bf16_t* Z = (const bf16_t*)(ws + WS_R1);
    LAS float* imp = (LAS float*)(lds + L_IMP); LAS unsigned* sel = (LAS unsigned*)(lds + L_SEL); LAS unsigned* uni = (LAS unsigned*)(lds + L_UNI);
    LAS int* cnt = (LAS int*)(lds + L_CNT); LAS int* LC = (LAS int*)(lds + L_LC); LAS int* LW = (LAS int*)(lds + L_LW); LAS int* LS = (LAS int*)(lds + L_LS);
    LAS float* li_l = (LAS float*)(lds + L_WS) + wid * 64;
    const int t0 = 64 * qt, cur = qt;
    __syncthreads();
    for (int i = tid; i < 64 * IMP_LD; i += NTHREADS) imp[i] = 0.f;
    if (tid < 4) uni[tid] = 0u;
    if (tid == 0) { const int nc = ((4 * qt + 2) >> 6) + 1; for (int i = 0; i < nc; ++i) LC[i] = nc - 1 - i; cnt[0] = nc;
        const int b0 = qt > 8 ? qt - 8 : 0, nw = qt - b0 + 1; for (int i = 0; i < nw; ++i) LW[i] = qt - i; cnt[2] = nw; }
    __syncthreads();
    const int hh = r32 >> 3, jt = r32 & 7, tl = 8 * wid + jt, t = t0 + tl, head = g * 4 + hh;
    bf16x8 qr[8];
    { const bf16_t* Qrow = Z + (size_t)t * ZW + ZC_Q + head * 128 + hi * 8;
#pragma unroll
      for (int d0 = 0; d0 < 8; ++d0) qr[d0] = *(const bf16x8*)(Qrow + d0 * 16); }
    const float slope2 = __builtin_amdgcn_exp2f(-0.5f * (float)(head + 1)) * LOG2E;
    const bf16_t* gz = Z + (size_t)t * ZW + ZC_G + head * 3;
    const float g_cmp = sigmoidf_(bf2f(gz[0])), g_slc = sigmoidf_(bf2f(gz[1])), g_win = sigmoidf_(bf2f(gz[2]));
    const int nc = cnt[0], nw = cnt[2];
    f32x16 o[4]; float m_reg, l_reg;
    float* acc_g = (float*)(ws + WS_B) + (size_t)(t0 + 8 * wid) * 2048 + (size_t)g * 512;
    bf16_t* out_g = (bf16_t*)(ws + WS_NSA) + (size_t)(t0 + 8 * wid) * 2048 + (size_t)g * 512;
    const bf16_t* kc = (const bf16_t*)(ws + WS_KCVC) + (size_t)g * 512 * 128; const bf16_t* vc = kc + (size_t)4 * 512 * 128;
    flash<0>(lds, kc, vc, 128, LC, nc, qr, o, m_reg, l_reg, t, slope2, sel, (4 * qt - 1) >> 6, -1, tid, wid, lane);
    const float inv_lc = l_reg > 0.f ? 1.f / l_reg : 0.f;
    accum_branch<0>(acc_g, out_g, o, g_cmp * inv_lc, li_l, r32, hi);
    { const float m_c = m_reg;
      LAS char* K_lds = lds + L_K;
      __syncthreads();
      { int offK[2], offV[2]; dma_offsets(128, wid, lane, offK, offV); dma_tile(K_lds, kc, 0, offK, wid); }
      VM_WAIT(); __syncthreads();
#pragma unroll 1
      for (int i = 0; i < nc; ++i) {
        if (i + 1 < nc) { int offK[2], offV[2]; dma_offsets(128, wid, lane, offK, offV); dma_tile(K_lds + ((i + 1) & 1) * SHM, kc, (size_t)(i + 1) * 64 * 128, offK, wid); }
        f32x16 p0, p1;
        qkt(p0, p1, K_lds + (i & 1) * SHM, qr, r32, hi);
        bias_mask<0>(p0, p1, i, t, hi, slope2, true);
#pragma unroll
        for (int r = 0; r < 16; ++r) { float v0 = __builtin_amdgcn_exp2f(p0[r] - m_c) * inv_lc, v1 = __builtin_amdgcn_exp2f(p1[r] - m_c) * inv_lc;
            v0 += __int_as_float(__builtin_amdgcn_update_dpp(0, __float_as_int(v0), 0x128, 0xf, 0xf, false)); v1 += __int_as_float(__builtin_amdgcn_update_dpp(0, __float_as_int(v1), 0x128, 0xf, 0xf, false));
            { auto q0 = __builtin_amdgcn_permlane16_swap(__float_as_uint(v0), __float_as_uint(v0), false, false); v0 = __uint_as_float(q0[0]) + __uint_as_float(q0[1]); }
            { auto q1 = __builtin_amdgcn_permlane16_swap(__float_as_uint(v1), __float_as_uint(v1), false, false); v1 = __uint_as_float(q1[0]) + __uint_as_float(q1[1]); }
            p0[r] = v0; p1[r] = v1; }
        if (r32 < 8) {
            LAS float* row = imp + tl * IMP_LD + 16 * i + hi;
#pragma unroll
            for (int a4 = 0; a4 < 4; ++a4) {
                const float s0 = (p0[4 * a4] + p0[4 * a4 + 1]) + (p0[4 * a4 + 2] + p0[4 * a4 + 3]), s1 = (p1[4 * a4] + p1[4 * a4 + 1]) + (p1[4 * a4 + 2] + p1[4 * a4 + 3]);
                atomicAdd((float*)(row + 2 * a4), s0); atomicAdd((float*)(row + 2 * a4 + 8), s1);
                atomicAdd((float*)(row + 2 * a4 + 1), p0[4 * a4 + 3]); atomicAdd((float*)(row + 2 * a4 + 9), p1[4 * a4 + 3]); }
        }
        VM_WAIT();
        __syncthreads();
      }
    }
    LDS_WAIT();
    {
        unsigned key0[8], key1[8], w0[8], w1[8], w2[8], w3[8];
#pragma unroll
        for (int j = 0; j < 8; ++j) { const LAS float* row = imp + (8 * wid + j) * IMP_LD;
            { const int kk = lane; const unsigned bits = __float_as_uint(row[kk]);
              key0[j] = (kk > cur) ? 0u : (kk == 0 || kk == cur || kk == cur - 1) ? (0xFFFFFF80u | (unsigned)(127 - kk)) : ((((bits >> 7) + 1u) << 7) | (unsigned)(127 - kk)); }
            { const int kk = lane + 64; const unsigned bits = __float_as_uint(row[kk]);
              key1[j] = (kk > cur) ? 0u : (kk == cur || kk == cur - 1) ? (0xFFFFFF80u | (unsigned)(127 - kk)) : ((((bits >> 7) + 1u) << 7) | (unsigned)(127 - kk)); }
            w0[j] = 0u; w1[j] = 0u; w2[j] = 0u; w3[j] = 0u; }
        for (int it = 0; it < 16; ++it) {
#pragma unroll
            for (int j = 0; j < 8; ++j) {
                const unsigned M = __reduce_max_sync(~0ull, key0[j] > key1[j] ? key0[j] : key1[j]);
                const unsigned kk = 127u - (M & 127u), bit = (M != 0u) ? (1u << (kk & 31u)) : 0u, wq = kk >> 5;
                w0[j] |= (wq == 0u) ? bit : 0u; w1[j] |= (wq == 1u) ? bit : 0u; w2[j] |= (wq == 2u) ? bit : 0u; w3[j] |= (wq == 3u) ? bit : 0u;
                key0[j] = (key0[j] == M) ? 0u : key0[j]; key1[j] = (key1[j] == M) ? 0u : key1[j];
            }
        }
        if (lane == 0) {
#pragma unroll
            for (int j = 0; j < 8; ++j) { const int tj = 8 * wid + j; sel[tj * 4 + 0] = w0[j]; sel[tj * 4 + 1] = w1[j]; sel[tj * 4 + 2] = w2[j]; sel[tj * 4 + 3] = w3[j];
                atomicOr((unsigned*)&uni[0], w0[j]); atomicOr((unsigned*)&uni[1], w1[j]); atomicOr((unsigned*)&uni[2], w2[j]); atomicOr((unsigned*)&uni[3], w3[j]); }
        }
    }
    __syncthreads();
    if (tid < 128) {
        const unsigned u0 = uni[0], u1 = uni[1], u2 = uni[2], u3 = uni[3]; const int b = tid, wq = b >> 5, sh = b & 31;
        const unsigned uw = (wq == 0) ? u0 : (wq == 1) ? u1 : (wq == 2) ? u2 : u3;
        if ((uw >> sh) & 1u) { int rank = (sh == 31) ? 0 : __builtin_popcount(uw >> (sh + 1));
            if (wq < 1) rank += __builtin_popcount(u1); if (wq < 2) rank += __builtin_popcount(u2); if (wq < 3) rank += __builtin_popcount(u3);
            LS[rank] = b; }
        if (tid == 0) cnt[1] = __builtin_popcount(u0) + __builtin_popcount(u1) + __builtin_popcount(u2) + __builtin_popcount(u3);
    }
    __syncthreads();
    const int ns = cnt[1];
    flash<1>(lds, Z + ZC_KV + (2 * 4 + g) * 128, Z + ZC_KV + (3 * 4 + g) * 128, ZW, LS, ns, qr, o, m_reg, l_reg, t, slope2, sel + tl * 4, cur, -1, tid, wid, lane);
    accum_branch<1>(acc_g, out_g, o, l_reg > 0.f ? g_slc / l_reg : 0.f, li_l, r32, hi);
    flash<2>(lds, Z + ZC_KV + (4 * 4 + g) * 128, Z + ZC_KV + (5 * 4 + g) * 128, ZW, LW, nw, qr, o, m_reg, l_reg, t, slope2, sel, cur, cur - 8, tid, wid, lane);
    accum_branch<2>(acc_g, out_g, o, l_reg > 0.f ? g_win / l_reg : 0.f, li_l, r32, hi, (unsigned*)(ws + WS_CTL) + CW_ROWMAX_N + t0 + 8 * wid);
}
#undef KSWZ
#undef SBAR
}

__device__ __forceinline__ void phase_attention(const Frame& F, const Args& a) {
    for (int L = F.bid; L < 512; L += F.G) { const int g = L & 3, qt = (L < 256) ? 127 - (L >> 2) : ((L - 256) >> 2); at::attn_unit(F, a.ws, g, qt); }
}


namespace pk {
constexpr int SC_LD = 132;
__device__ __forceinline__ int crow(int r, int hi) { return (r & 3) + 8 * (r >> 2) + 4 * hi; }
__device__ __forceinline__ void sort16_desc(unsigned (&a)[16]) {
#pragma unroll
    for (int k = 2; k <= 16; k <<= 1)
#pragma unroll
        for (int j = k >> 1; j > 0; j >>= 1)
#pragma unroll
            for (int i = 0; i < 16; ++i) { const int l = i ^ j; if (l > i) { const unsigned mx = a[i] > a[l] ? a[i] : a[l], mn = a[i] > a[l] ? a[l] : a[i]; const bool desc = ((i & k) == 0);
                a[i] = desc ? mx : mn; a[l] = desc ? mn : mx; } }
}
__device__ __forceinline__ void merge16_desc(unsigned (&a)[16], unsigned (&b)[16]) {
#pragma unroll
    for (int i = 0; i < 16; ++i) a[i] = a[i] > b[15 - i] ? a[i] : b[15 - i];
#pragma unroll
    for (int j = 8; j > 0; j >>= 1)
#pragma unroll
        for (int i = 0; i < 16; ++i) { const int l = i ^ j; if (l > i) { const unsigned mx = a[i] > a[l] ? a[i] : a[l], mn = a[i] > a[l] ? a[l] : a[i]; a[i] = mx; a[l] = mn; } }
}
__device__ __forceinline__ void score_tile(const Frame& F, unsigned char* ws, int tile) {
    LAS float* sc = (LAS float*)F.lds;
    const int tid = F.tid, wid = F.wave, lane = F.lane, r32 = lane & 31, hi = lane >> 5;
    const bf16_t* qp = (const bf16_t*)(ws + WS_B); const bf16_t* keys = (const bf16_t*)(ws + WS_SMALL + 4096);
    const int t0 = tile * 16;
    {
        const int side = wid >> 2, rho = 32 * (wid & 3) + r32, tl = rho >> 3, head = rho & 7;
        const bf16_t* qrow = qp + (size_t)(t0 + tl) * 2048 + head * 256 + side * 128 + hi * 8;
        bf16x8 qf[8];
#pragma unroll
        for (int d0 = 0; d0 < 8; ++d0) qf[d0] = *(const bf16x8*)(qrow + d0 * 16);
        const bf16_t* kb_ = keys + (size_t)side * 128 * 128 + (size_t)r32 * 128 + hi * 8;
        f32x16 acc[4]; bf16x8 ka[2][8];
#pragma unroll
        for (int d0 = 0; d0 < 8; ++d0) ka[0][d0] = *(const bf16x8*)(kb_ + d0 * 16);
#pragma unroll
        for (int kb = 0; kb < 4; ++kb) { acc[kb] = f32x16{};
            if (kb < 3) {
#pragma unroll
                for (int d0 = 0; d0 < 8; ++d0) ka[(kb + 1) & 1][d0] = *(const bf16x8*)(kb_ + (size_t)(kb + 1) * 32 * 128 + d0 * 16); }
            __builtin_amdgcn_sched_barrier(0);
#pragma unroll
            for (int d0 = 0; d0 < 8; ++d0) acc[kb] = __builtin_amdgcn_mfma_f32_32x32x16_bf16(ka[kb & 1][d0], qf[d0], acc[kb], 0, 0, 0);
            __builtin_amdgcn_sched_barrier(0); }
        LAS float* row = sc + (side * 128 + rho) * SC_LD;
#pragma unroll
        for (int kb = 0; kb < 4; ++kb)
#pragma unroll
            for (int a4 = 0; a4 < 4; ++a4) *(LAS f32x4*)(row + kb * 32 + 8 * a4 + 4 * hi) = (f32x4){acc[kb][4 * a4], acc[kb][4 * a4 + 1], acc[kb][4 * a4 + 2], acc[kb][4 * a4 + 3]};
    }
    __syncthreads();
    if (tid < 256) {
        LAS float* row = sc + tid * SC_LD;
        unsigned best[16];
#pragma unroll 1
        for (int g = 0; g < 8; ++g) {
            unsigned a[16];
#pragma unroll
            for (int q = 0; q < 4; ++q) { const f32x4 v = *(const LAS f32x4*)(row + 16 * g + 4 * q);
#pragma unroll
                for (int e = 0; e < 4; ++e) { const unsigned u = __float_as_uint(v[e]); const unsigned ord = u ^ ((unsigned)((int)u >> 31) | 0x80000000u);
                    a[4 * q + e] = (ord & 0xFFFFFF80u) | (unsigned)(127 - (16 * g + 4 * q + e)); } }
            sort16_desc(a);
            if (g == 0) {
#pragma unroll
                for (int i = 0; i < 16; ++i) best[i] = a[i];
            } else merge16_desc(best, a);
        }
        float bv[16];
#pragma unroll
        for (int i = 0; i < 16; ++i) { const int idx = 127 - (int)(best[i] & 127u); bv[i] = row[idx]; best[i] = (unsigned)idx; }
#pragma unroll
        for (int i = 0; i < 16; ++i) { row[i] = bv[i]; row[16 + i] = __int_as_float((int)best[i]); }
    }
    __syncthreads();
    if (tid < 128) {
        const LAS float* r1 = sc + tid * SC_LD; const LAS float* r2 = sc + (128 + tid) * SC_LD;
        float v1[16], v2[16];
#pragma unroll
        for (int i = 0; i < 16; ++i) { v1[i] = r1[i]; v2[i] = r2[i]; }
        unsigned c[64];
#pragma unroll
        for (int i = 0; i < 64; ++i) c[i] = 0u;
        {
            int n = 0;
#pragma unroll
            for (int a = 0; a < 16; ++a)
#pragma unroll
                for (int b = 0; b < 16; ++b) if ((a + 1) * (b + 1) <= 16) { const unsigned u = __float_as_uint(v1[a] + v2[b]); const unsigned ord = u ^ ((unsigned)((int)u >> 31) | 0x80000000u);
                    c[n] = (ord & 0xFFFFFF00u) | (unsigned)(255 - (a * 16 + b)); ++n; }
        }
        unsigned best[16], g1[16], g2[16], g3[16];
#pragma unroll
        for (int i = 0; i < 16; ++i) { best[i] = c[i]; g1[i] = c[16 + i]; g2[i] = c[32 + i]; g3[i] = c[48 + i]; }
        sort16_desc(best); sort16_desc(g1); sort16_desc(g2); sort16_desc(g3);
        merge16_desc(best, g1); merge16_desc(g2, g3); merge16_desc(best, g2);
        float val[16]; int ex[16];
#pragma unroll
        for (int i = 0; i < 16; ++i) { const int fl = 255 - (int)(best[i] & 255u), a = fl >> 4, b = fl & 15;
            val[i] = r1[a] + r2[b]; ex[i] = __float_as_int(r1[16 + a]) * 128 + __float_as_int(r2[16 + b]); }
        float smax = val[0];
#pragma unroll
        for (int i = 1; i < 16; ++i) smax = fmaxf(smax, val[i]);
        float ssum = 0.f, gsm[16];
#pragma unroll
        for (int i = 0; i < 16; ++i) { gsm[i] = __builtin_amdgcn_exp2f((val[i] - smax) * 1.4426950408889634f); ssum += gsm[i]; }
        const float inv = 1.f / ssum;
        const int tl = tid >> 3, head = tid & 7;
        int* pe = (int*)(ws + WS_PE) + (size_t)(t0 + tl) * 128 + head * 16; float* pg = (float*)(ws + WS_PG) + (size_t)(t0 + tl) * 128 + head * 16;
#pragma unroll
        for (int q = 0; q < 4; ++q) { *(int4*)(pe + 4 * q) = make_int4(ex[4 * q], ex[4 * q + 1], ex[4 * q + 2], ex[4 * q + 3]);
            *(f32x4*)(pg + 4 * q) = (f32x4){gsm[4 * q] * inv, gsm[4 * q + 1] * inv, gsm[4 * q + 2] * inv, gsm[4 * q + 3] * inv}; }
    }
    __syncthreads();
}
}
__device__ __forceinline__ void phase_peer_score(const Frame& F, const Args& a) { for (int tile = F.bid; tile < T / 16; tile += F.G) pk::score_tile(F, a.ws, tile); }

__device__ __forceinline__ float gelu_tanh(float a) {
    const float y = 0.7978845608028654f * (a + 0.044715f * a * a * a);
    const float th = 1.f - 2.f * __builtin_amdgcn_rcpf(1.f + __builtin_amdgcn_exp2f(2.8853900817779268f * y));
    return 0.5f * a * (1.f + th);
}
constexpr size_t PT_V8 = (size_t)64 * MiB, PT_US = (size_t)128 * MiB, PT_VS = PT_US + 65536, PT_SLICE = (size_t)16384 * 256;
__device__ __forceinline__ float wave_max(float v) {
#pragma unroll
    for (int o = 1; o < 64; o <<= 1) v = fmaxf(v, __shfl_xor(v, o));
    return v;
}
__device__ __forceinline__ void cvt_row_fp8(const float* src, unsigned char* tab, int e, float* inv_out, int lane) {
    const f32x4* sp = (const f32x4*)src + lane; f32x4 v[16]; float amax = 0.f;
#pragma unroll
    for (int j = 0; j < 16; ++j) { v[j] = sp[64 * j]; amax = fmaxf(fmaxf(amax, fmaxf(fabsf(v[j].x), fabsf(v[j].y))), fmaxf(fabsf(v[j].z), fabsf(v[j].w))); }
    amax = wave_max(amax);
    const int ef = (int)((__float_as_uint(amax) >> 23) & 0xffu);
    const int ex = (ef >= 64 && ef < 250) ? ef - 126 : 8;
    const float scale = __uint_as_float((unsigned)(127 + 8 - ex) << 23), inv = __uint_as_float((unsigned)(127 - 8 + ex) << 23);
#pragma unroll
    for (int j = 0; j < 16; ++j) { int pk = __builtin_amdgcn_cvt_pk_fp8_f32(v[j].x * scale, v[j].y * scale, 0, false); pk = __builtin_amdgcn_cvt_pk_fp8_f32(v[j].z * scale, v[j].w * scale, pk, true);
        ((unsigned*)(tab + (size_t)j * PT_SLICE + (size_t)e * 256))[lane] = (unsigned)pk; }
    if (lane == 0) *inv_out = inv;
}
__device__ __forceinline__ void cvt_row_i8(const float* src, unsigned char* tab, int e, float* inv_out, int lane) {
    const f32x4* sp = (const f32x4*)src + lane; f32x4 v[16]; float amax = 0.f;
#pragma unroll
    for (int j = 0; j < 16; ++j) { v[j] = sp[64 * j]; amax = fmaxf(fmaxf(amax, fmaxf(fabsf(v[j].x), fabsf(v[j].y))), fmaxf(fabsf(v[j].z), fabsf(v[j].w))); }
    amax = wave_max(amax);
    const float scale = amax > 0.f ? 127.f / amax : 0.f;
#pragma unroll
    for (int j = 0; j < 16; ++j) ((unsigned*)(tab + (size_t)j * PT_SLICE + (size_t)e * 256))[lane] = pack_i8x4(v[j].x * scale, v[j].y * scale, v[j].z * scale, v[j].w * scale);
    if (lane == 0) *inv_out = amax * (1.f / 127.f);
}
__device__ __forceinline__ void pt_load(const float* tu, const float* tv, f32x4* v, int r, int lane) {
    const f32x4* sp = (const f32x4*)(((r >> 14) ? tv : tu) + (size_t)(r & 16383) * D) + lane;
#pragma unroll
    for (int j = 0; j < 16; ++j) v[j] = sp[64 * j];
}
__device__ __forceinline__ void pt_proc(unsigned char* PT, const f32x4* v, int r, int lane) {
    const int tb = r >> 14, e = r & 16383; unsigned char* tab = PT + (tb ? PT_V8 : 0); float amax = 0.f;
#pragma unroll
    for (int j = 0; j < 16; ++j) amax = fmaxf(fmaxf(amax, fmaxf(fabsf(v[j].x), fabsf(v[j].y))), fmaxf(fabsf(v[j].z), fabsf(v[j].w)));
    amax = wave_max(amax); const float scale = amax > 0.f ? 127.f / amax : 0.f;
#pragma unroll
    for (int j = 0; j < 16; ++j) ((unsigned*)(tab + (size_t)j * PT_SLICE + (size_t)e * 256))[lane] = pack_i8x4(v[j].x * scale, v[j].y * scale, v[j].z * scale, v[j].w * scale);
    if (lane == 0) ((float*)(PT + (tb ? PT_VS : PT_US)))[e] = amax * (1.f / 127.f);
}
__device__ __forceinline__ void phase_peer_tables(const Frame& F, const Args& a, int r_lo, int r_hi, int gw, int NGW) {
    unsigned char* PT = a.ws + WS_PT; const int lane = F.lane;
    int r = r_lo + gw; if (r >= r_hi) return;
    f32x4 vA[16], vB[16];
    pt_load(a.in[17], a.in[18], vA, r, lane);
    for (;;) {
        const int r1 = r + NGW; const bool h1 = r1 < r_hi;
        if (h1) pt_load(a.in[17], a.in[18], vB, r1, lane);
        pt_proc(PT, vA, r, lane);
        if (!h1) break;
        const int r2 = r1 + NGW; const bool h2 = r2 < r_hi;
        if (h2) pt_load(a.in[17], a.in[18], vA, r2, lane);
        pt_proc(PT, vB, r1, lane);
        if (!h2) break;
        r = r2;
    }
}
struct TableSide { static constexpr bool ON = true; const Frame* F; const Args* a; int slot, on;
    __device__ void after(int ui) const { if (on && ui == slot) { f32x4 sv[16];
        for (int k = 0; k < 8; ++k) { const int r = F->vid * 64 + 8 * k + F->wave; pt_load(a->in[17], a->in[18], sv, r, F->lane); pt_proc(a->ws + WS_PT, sv, r, F->lane); } } } };
__device__ __forceinline__ int idot16(u32x4 w, u32x4 h) {
    int r = __builtin_amdgcn_sdot4((int)w.x, (int)h.x, 0, false); r = __builtin_amdgcn_sdot4((int)w.y, (int)h.y, r, false);
    r = __builtin_amdgcn_sdot4((int)w.z, (int)h.z, r, false); return __builtin_amdgcn_sdot4((int)w.w, (int)h.w, r, false);
}
__device__ __forceinline__ f32x2 dot16(u32x4 w, const f32x2* h, f32x2 s) {
    s = __builtin_elementwise_fma(__builtin_amdgcn_cvt_pk_f32_fp8((int)w.x, false), h[0], s); s = __builtin_elementwise_fma(__builtin_amdgcn_cvt_pk_f32_fp8((int)w.x, true), h[1], s);
    s = __builtin_elementwise_fma(__builtin_amdgcn_cvt_pk_f32_fp8((int)w.y, false), h[2], s); s = __builtin_elementwise_fma(__builtin_amdgcn_cvt_pk_f32_fp8((int)w.y, true), h[3], s);
    s = __builtin_elementwise_fma(__builtin_amdgcn_cvt_pk_f32_fp8((int)w.z, false), h[4], s); s = __builtin_elementwise_fma(__builtin_amdgcn_cvt_pk_f32_fp8((int)w.z, true), h[5], s);
    s = __builtin_elementwise_fma(__builtin_amdgcn_cvt_pk_f32_fp8((int)w.w, false), h[6], s); s = __builtin_elementwise_fma(__builtin_amdgcn_cvt_pk_f32_fp8((int)w.w, true), h[7], s);
    return s;
}
__device__ __forceinline__ void axpy16(u32x4 w, float co, f32x2* acc) {
    const f32x2 c2 = {co, co};
    acc[0] = __builtin_elementwise_fma(c2, __builtin_amdgcn_cvt_pk_f32_fp8((int)w.x, false), acc[0]); acc[1] = __builtin_elementwise_fma(c2, __builtin_amdgcn_cvt_pk_f32_fp8((int)w.x, true), acc[1]);
    acc[2] = __builtin_elementwise_fma(c2, __builtin_amdgcn_cvt_pk_f32_fp8((int)w.y, false), acc[2]); acc[3] = __builtin_elementwise_fma(c2, __builtin_amdgcn_cvt_pk_f32_fp8((int)w.y, true), acc[3]);
    acc[4] = __builtin_elementwise_fma(c2, __builtin_amdgcn_cvt_pk_f32_fp8((int)w.z, false), acc[4]); acc[5] = __builtin_elementwise_fma(c2, __builtin_amdgcn_cvt_pk_f32_fp8((int)w.z, true), acc[5]);
    acc[6] = __builtin_elementwise_fma(c2, __builtin_amdgcn_cvt_pk_f32_fp8((int)w.w, false), acc[6]); acc[7] = __builtin_elementwise_fma(c2, __builtin_amdgcn_cvt_pk_f32_fp8((int)w.w, true), acc[7]);
}
__device__ __forceinline__ void phase_peer_a(const Frame& F, const Args& a, const int emask, float* PA) {
    unsigned char* ws = a.ws;
    const unsigned char* U8 = ws + WS_PT; const unsigned char* H2Q = ws + WS_NSA; const int* PE = (const int*)(ws + WS_PE);
    const int lane = F.lane, rg = lane >> 4, li = lane & 15, xs = F.vid & 7, rank = F.vid >> 3, nrank = (F.G - xs + 7) >> 3, step = nrank * 8;
    LAS int* lpe = (LAS int*)(F.lds + F.wave * 2048);
    const bool b3 = li & 8, b2 = li & 4, b1 = li & 2, b0 = li & 1;
#define PA_LOADS(dst, buf, half) do { _Pragma("unroll") for (int j = 0; j < 16; ++j) { const unsigned e = (unsigned)lpe[(buf) * 128 + 4 * ((half) * 16 + j) + rg]; dst[j] = *(const u32x4*)(Us + (size_t)(e * 256u + lo16)); } } while (0)
    const unsigned lo16 = (unsigned)li * 16u;
    for (int pass = 0; pass < 2; ++pass) { const int sl = pass * 8 + xs; const unsigned char* Us = U8 + (size_t)sl * PT_SLICE;
        int tok = rank * 8 + F.wave;
        if (tok >= T) continue;
        u32x4 hq0, hn0 = {0, 0, 0, 0}; int pn0 = 0, pn1 = 0;
        { hq0 = *(const u32x4*)(H2Q + (size_t)tok * D + sl * 256 + li * 16);
          lpe[lane] = PE[(size_t)tok * 128 + lane] & emask; lpe[64 + lane] = PE[(size_t)tok * 128 + 64 + lane] & emask; lpe[128 + lane] = 0; lpe[192 + lane] = 0;
          if (tok + step < T) { pn0 = PE[(size_t)(tok + step) * 128 + lane]; pn1 = PE[(size_t)(tok + step) * 128 + 64 + lane]; } }
        LDS_WAIT();
        u32x4 wA[16], wB[16];
        PA_LOADS(wA, 0, 0);
        int cur = 0;
        for (; tok < T; tok += step) {
            const int tn = tok + step; const bool has_next = tn < T;
            if (has_next) { lpe[(cur ^ 1) * 128 + lane] = pn0 & emask; lpe[(cur ^ 1) * 128 + 64 + lane] = pn1 & emask;
                hn0 = *(const u32x4*)(H2Q + (size_t)tn * D + sl * 256 + li * 16);
                if (tn + step < T) { pn0 = PE[(size_t)(tn + step) * 128 + lane]; pn1 = PE[(size_t)(tn + step) * 128 + 64 + lane]; } }
            PA_LOADS(wB, cur, 1);
            int v[32];
#pragma unroll
            for (int j = 0; j < 16; ++j) v[j] = idot16(wA[j], hq0);
            LDS_WAIT();
            PA_LOADS(wA, cur ^ 1, 0);
#pragma unroll
            for (int j = 0; j < 16; ++j) v[16 + j] = idot16(wB[j], hq0);
#define PA_STEP(N, B, CTRL) _Pragma("unroll") for (int i = 0; i < N; ++i) { const int snd = B ? v[i] : v[N + i], kp = B ? v[N + i] : v[i]; v[i] = kp + __builtin_amdgcn_update_dpp(0, snd, CTRL, 0xf, 0xf, false); }
            PA_STEP(16, b3, 0x128) PA_STEP(8, b2, 0x141) PA_STEP(4, b1, 0x4E) PA_STEP(2, b0, 0xB1)
#undef PA_STEP
            float* pa = PA + ((size_t)sl * T + tok) * 128 + rg;
            pa[4 * (2 * li)] = (float)v[0]; pa[4 * (2 * li + 1)] = (float)v[1];
            hq0 = hn0; cur ^= 1;
        }
        LDS_WAIT();
    }
#undef PA_LOADS
}
__device__ __forceinline__ void phase_peer_coef(const Frame& F, const Args& a) {
    unsigned char* ws = a.ws; const float* PA = (const float*)(ws + WS_B); const int* PE = (const int*)(ws + WS_PE); const float* PG = (const float*)(ws + WS_PG);
    const float* US = (const float*)(ws + WS_PT + PT_US); const float* VS = (const float*)(ws + WS_PT + PT_VS); const float* SH = (const float*)(ws + WS_SMALL + 262144);
    signed char* CQ = (signed char*)(ws + WS_HCMP); float* CSC = (float*)(ws + WS_SMALL + 524288);
    const int gw = F.bid * NWAVES + F.wave, NGW = F.G * NWAVES, lane = F.lane;
    for (int tok0 = gw; tok0 < T; tok0 += 4 * NGW) { float s0[4], s1[4]; int e0[4], e1[4]; float sh[4], g0[4], g1[4]; size_t i0[4];
#pragma unroll
        for (int r = 0; r < 4; ++r) { const int tok = (tok0 + r * NGW < T) ? tok0 + r * NGW : tok0; i0[r] = (size_t)tok * 128 + lane; s0[r] = 0.f; s1[r] = 0.f;
#pragma unroll
            for (int sl = 0; sl < 16; ++sl) { s0[r] += PA[(size_t)sl * T * 128 + i0[r]]; s1[r] += PA[(size_t)sl * T * 128 + i0[r] + 64]; }
            e0[r] = PE[i0[r]]; e1[r] = PE[i0[r] + 64]; sh[r] = SH[tok]; g0[r] = PG[i0[r]]; g1[r] = PG[i0[r] + 64]; }
        float u0[4], u1[4], w0[4], w1[4];
#pragma unroll
        for (int r = 0; r < 4; ++r) { u0[r] = US[e0[r]]; u1[r] = US[e1[r]]; w0[r] = VS[e0[r]]; w1[r] = VS[e1[r]]; }
#pragma unroll
        for (int r = 0; r < 4; ++r) { const int tok = tok0 + r * NGW;
            if (tok < T) { const float c0 = g0[r] * gelu_tanh(s0[r] * u0[r] * sh[r]) * w0[r], c1 = g1[r] * gelu_tanh(s1[r] * u1[r] * sh[r]) * w1[r];
                float amax = fmaxf(fabsf(c0), fabsf(c1));
#pragma unroll
                for (int o = 1; o < 64; o <<= 1) amax = fmaxf(amax, __shfl_xor(amax, o));
                const float sc = amax > 0.f ? 127.f / amax : 0.f;
                CQ[i0[r]] = (signed char)(int)__builtin_rintf(c0 * sc); CQ[i0[r] + 64] = (signed char)(int)__builtin_rintf(c1 * sc);
                if (lane == 0) CSC[tok] = amax * (1.f / 127.f); } } }
}
__device__ __forceinline__ void phase_peer_v(const Frame& F, const Args& a, const bool dry) {
    unsigned char* ws = a.ws;
    const unsigned char* V8 = ws + WS_PT + PT_V8; const int* PE = (const int*)(ws + WS_PE); const unsigned* CQ = (const unsigned*)(ws + WS_HCMP); const float* CSC = (const float*)(ws + WS_SMALL + 524288); bf16_t* X = (bf16_t*)(ws + WS_XB);
    const int lane = F.lane, rg = lane >> 4, li = lane & 15, xs = F.vid & 7, rank = F.vid >> 3, nrank = (F.G - xs + 7) >> 3;
    LAS int* lpe = (LAS int*)(F.lds + F.wave * 2048); LAS unsigned* lcq = (LAS unsigned*)(lpe + 128);
    const int dsel = li >> 2, bsh = (li & 3) * 8;
    for (int pass = 0; pass < 2; ++pass) { const int sl = pass * 8 + xs; const unsigned char* Vs = V8 + (size_t)sl * PT_SLICE + li * 16;
        int tok = rank * 8 + F.wave;
        int pn0 = 0, pn1 = 0; unsigned cn = 0u;
        if (tok < T) { pn0 = PE[(size_t)tok * 128 + lane]; pn1 = PE[(size_t)tok * 128 + 64 + lane]; cn = CQ[(size_t)tok * 32 + (lane & 31)]; }
        for (; tok < T; tok += nrank * 8) {
            lpe[lane] = pn0; lpe[64 + lane] = pn1; if (lane < 32) lcq[lane] = cn;
            LDS_WAIT();
            { const int tn = tok + nrank * 8; if (tn < T) { pn0 = PE[(size_t)tn * 128 + lane]; pn1 = PE[(size_t)tn * 128 + 64 + lane]; cn = CQ[(size_t)tn * 32 + (lane & 31)]; } }
            u32x2* xp = (u32x2*)(X + (size_t)tok * D + sl * 256 + li * 16 + rg * 4);
            const u32x2 xb = *xp; const f32x4 xq = {bflo(xb.x), bfhi(xb.x), bflo(xb.y), bfhi(xb.y)};
            const float csc = CSC[tok];
            i32x4 acc = {0, 0, 0, 0};
#pragma unroll
            for (int q8 = 0; q8 < 32 / PS_B; ++q8) { u32x4 w[PS_B]; unsigned cd[PS_B];
#pragma unroll
                for (int j = 0; j < PS_B; ++j) { const int q = q8 * PS_B + j; const int e = lpe[4 * q + rg]; cd[j] = lcq[q]; w[j] = *(const u32x4*)(Vs + (size_t)e * 256); }
#pragma unroll
                for (int j = 0; j < PS_B; ++j) { const unsigned cb = ((cd[j] >> (8 * rg)) & 255u) << bsh;
                    const u32x4 av = {dsel == 0 ? cb : 0u, dsel == 1 ? cb : 0u, dsel == 2 ? cb : 0u, dsel == 3 ? cb : 0u};
                    acc = __builtin_amdgcn_mfma_i32_16x16x64_i8(__builtin_bit_cast(i32x4, av), __builtin_bit_cast(i32x4, w[j]), acc, 0, 0, 0); } }
            if (!dry) { f32x4 x0 = xq; x0.x += (float)acc[0] * csc; x0.y += (float)acc[1] * csc; x0.z += (float)acc[2] * csc; x0.w += (float)acc[3] * csc; *xp = (u32x2){cvtpk(x0.x, x0.y), cvtpk(x0.z, x0.w)}; }
            LDS_WAIT();
        }
    }
}

template <bool OUT_F32>
__device__ __forceinline__ void phase_norm(const Frame& F, const float* X, const float* gain, void* out) {
    const int gw = F.bid * NWAVES + F.wave, NGW = F.G * NWAVES;
    for (int m = gw; m < T; m += NGW) rms_row<OUT_F32>(X + (size_t)m * D, gain, OUT_F32 ? (void*)((float*)out + (size_t)m * D) : (void*)((bf16_t*)out + (size_t)m * D), F.lane);
}

constexpr int NPH = 19;
__global__ void __launch_bounds__(NTHREADS, 2) fwd(Args args) {
    extern __shared__ __attribute__((aligned(16))) unsigned char lds_raw[];
    Frame F; F.lds = (LAS unsigned char*)lds_raw; F.tid = threadIdx.x; F.lane = F.tid & 63; F.wave = __builtin_amdgcn_readfirstlane(F.tid >> 6); F.G = gridDim.x; F.bid = blockIdx.x;
    volatile LAS unsigned* MISC = (volatile LAS unsigned*)(F.lds + MISC_OFF);
    if (F.tid < 32) MISC[F.tid] = 0u;
    __syncthreads();
    unsigned char* ws = args.ws;
    const int lo = args.ph_lo, hi = args.ph_hi;
    XcdBarrier bar; bar.bar = (unsigned*)(ws + WS_CTL) + CW_BAR; bar.x = 0; bar.st = MISC + 8;
    if (hi - lo > 1) bar = xcd_barrier_post((unsigned*)(ws + WS_CTL) + CW_BAR, MISC + 8);
    F.vid = F.bid;
    unsigned* xrank = (unsigned*)(ws + WS_CTL) + 1024;
    if (hi - lo > 1) { if (F.tid == 0) { const unsigned x = xb_xcc_id(); MISC[16] = x; MISC[17] = xb_add(&xrank[64 * x], 1u); } }
#ifndef PH_MASK
#define PH_MASK 0xFFFFFFFFu
#endif
#define IN(k) (lo <= (k) && (k) < hi && ((PH_MASK >> (k)) & 1u))
#define SEAM(k) do { if (IN(k) && IN((k) + 1)) xcd_barrier(bar); } while (0)
#define REPS(k) ((PROBE_DUP == (k)) ? 2 : 1)
    bf16_t* Z = (bf16_t*)(ws + WS_R1);

    if (IN(0)) for (int rep = 0; rep < REPS(0); ++rep) { phase_prologue(F, args); SEAM(0); }
    if (IN(0) && IN(1) && (F.G & 7) == 0) {
        bool okv = true;
        for (int j = 0; j < 16; ++j) { const unsigned c = xb_ld(&xrank[64 * j]); okv = okv && (c == ((j < 8) ? (unsigned)(F.G >> 3) : 0u)); }
        if (okv) F.vid = (int)(MISC[17] * 8u + MISC[16]);
    }
    if (IN(1)) for (int rep = 0; rep < REPS(1); ++rep) {
        pg8::Gemm g{(const bf16_t*)(ws + WS_A), (const bf16_t*)(ws + WS_W_IN), D / 2, D / 2, D / 2}; pg8::Order<0> S; S.init(T / 256, ZW / 256, F.G, F.vid);
        pg8::EpiB<0, true> E{(const float*)(ws + SA_H), (const float*)(ws + SB_IN), Z, ZW, nullptr, nullptr, 0, (const bf16_t*)(ws + WS_ACMP), 0, ZC_Q / 256, ZC_KV / 256, at::CS, nullptr};
        const int side_rows = (F.G == 256) ? PT_SIDE_ROWS : 0;
        TableSide side{&F, &args, (F.vid & 7) % 7, side_rows != 0};
        pg8::gemm_phase<pg8::EpiB<0, true>, pg8::Order<0>, true, true, TableSide>(F.lds, g, S, E, side);
        { const int nwg = (T / 256) * (ZW / 256), rem = nwg % F.G;
          if (rem != 0 && F.vid >= rem) phase_peer_tables(F, args, side_rows, side_rows + PT_EARLY_ROWS, (F.vid - rem) * NWAVES + F.wave, (F.G - rem) * NWAVES);
          else if (rem == 0) phase_peer_tables(F, args, side_rows, side_rows + PT_EARLY_ROWS, F.bid * NWAVES + F.wave, F.G * NWAVES); }
        SEAM(1); }
    if (IN(3)) for (int rep = 0; rep < REPS(3); ++rep) {
        if (F.bid == 0 && F.tid < 256) { const int kv = F.tid >> 7, c = F.tid & 127; const float* part = (const float*)(ws + WS_SMALL + 131072) + (size_t)kv * 32 * 128 + c; float sb = 0.f;
            for (int w = 0; w < 32; ++w) sb += part[w * 128];
            ((float*)(ws + WS_SMALL))[F.tid] = sb; }
        { pg8::Gemm g{Z + ZC_POOL, (const bf16_t*)(ws + WS_W_POOL), 512, ZW, 512}; pg8::Order<1> S; S.init(T / 256, 8, F.G, F.vid);
          pg8::EpiB<1, false, false> E{nullptr, nullptr, (bf16_t*)(ws + WS_A) + (size_t)T * 2048, 2048, args.in[5], nullptr, 0, nullptr, 0, 0, 0, 1.f, nullptr};
          pg8::gemm_phase(F.lds, g, S, E); }
        { pg8::Gemm g{(const bf16_t*)(ws + WS_ACMP), (const bf16_t*)(ws + WS_W_CMP), 2048, 2048, 2048}; pg8::Order<2> S; S.init(16, 2, F.G, F.bid);
          pg8::EpiF<0> E{nullptr, nullptr, (float*)(ws + WS_HCMP), 512, nullptr, nullptr, 0};
          pg8::gemm_phase(F.lds, g, S, E); }
        SEAM(3); }
    if (IN(4)) for (int rep = 0; rep < REPS(4); ++rep) {
        phase_cmp_combine(F, args);
        pool_window_rows(F, (const bf16_t*)(ws + WS_A) + (size_t)T * 2048, ws + WS_A, (float*)(ws + SA_P));
        SEAM(4); }
    if (IN(5)) for (int rep = 0; rep < REPS(5); ++rep) { phase_attention(F, args); SEAM(5); }
    if (IN(6)) for (int rep = 0; rep < REPS(6); ++rep) {
        requant_rows<4>(F, (const bf16_t*)(ws + WS_NSA), ws + WS_ACMP, (const unsigned*)(ws + WS_CTL) + CW_ROWMAX_N, (float*)(ws + SA_N));
        SEAM(6); }
    if (IN(7)) for (int rep = 0; rep < REPS(7); ++rep) {
        { pg8::Gemm g{(const bf16_t*)(ws + WS_A), (const bf16_t*)(ws + WS_W_UPP), 1024, 1024, 1024}; pg8::Order<0> S; S.init(T / 256, D / 256, F.G, F.vid);
          pg8::EpiB<2, true> E{(const float*)(ws + SA_P), (const float*)(ws + SB_UPP), (bf16_t*)(ws + WS_C), D, nullptr, Z + ZC_GP, ZW, nullptr, 0, 0, 0, 1.f, nullptr};
          pg8::gemm_phase(F.lds, g, S, E); }
        { pg8::Gemm g{(const bf16_t*)(ws + WS_ACMP), (const bf16_t*)(ws + WS_W_UPN), 1024, 1024, 1024}; pg8::Order<0> S; S.init(T / 256, D / 256, F.G, F.vid);
          pg8::EpiB<3, true, true> E{(const float*)(ws + SA_N), (const float*)(ws + SB_UPN), (bf16_t*)(ws + WS_D), D, nullptr, Z + ZC_GN, ZW, (const bf16_t*)(ws + WS_C), D, 0, 0, 1.f, (unsigned*)(ws + WS_CTL) + CW_ROWMAX};
          pg8::gemm_phase(F.lds, g, S, E); }
        SEAM(7); }
    if (IN(8)) for (int rep = 0; rep < REPS(8); ++rep) {
        requant_rows<8>(F, (const bf16_t*)(ws + WS_D), ws + WS_C, (const unsigned*)(ws + WS_CTL) + CW_ROWMAX, (float*)(ws + SA_M));
        SEAM(8); }
    if (IN(9)) for (int rep = 0; rep < REPS(9); ++rep) {
        pg8::Gemm g{(const bf16_t*)(ws + WS_C), (const bf16_t*)(ws + WS_W_OUT), D / 2, D / 2, D / 2}; pg8::Order<0> S; S.init(T / 256, D / 256, F.G, F.vid);
        pg8::EpiB<4, true> E{(const float*)(ws + SA_M), (const float*)(ws + SB_OUT), (bf16_t*)(ws + WS_XB), D, args.in[0], nullptr, D, nullptr, 0, 0, 0, 1.f, nullptr};
        pg8::gemm_phase(F.lds, g, S, E);
        SEAM(9); }
    if (IN(10)) for (int rep = 0; rep < REPS(10); ++rep) {
        { const int gw8 = F.bid * NWAVES + F.wave, NGW8 = F.G * NWAVES;
          for (int m = gw8; m < T; m += NGW8) rms_row_i8_b((const bf16_t*)(ws + WS_XB) + (size_t)m * D, args.in[13], ws + WS_NSA + (size_t)m * D, (float*)(ws + WS_SMALL + 262144) + m, F.lane); }
        phase_peer_tables(F, args, ((F.G == 256) ? PT_SIDE_ROWS : 0) + PT_EARLY_ROWS, 32768, F.bid * NWAVES + F.wave, F.G * NWAVES);
        SEAM(10); }
    if (IN(11)) for (int rep = 0; rep < REPS(11); ++rep) {
        { pg8::Gemm g{(const bf16_t*)(ws + WS_NSA), (const bf16_t*)(ws + WS_W_PQ), D / 2, D / 2, D / 2}; pg8::Order<0> S; S.init(T / 256, 2048 / 256, F.G, F.vid);
          pg8::EpiB<0, true> E{(const float*)(ws + WS_SMALL + 262144), (const float*)(ws + SB_PQ), (bf16_t*)(ws + WS_B), 2048, nullptr, nullptr, 0, nullptr, 0, 0, 0, 1.f, nullptr};
          pg8::gemm_phase(F.lds, g, S, E); }
        SEAM(11); }
    if (IN(12)) for (int rep = 0; rep < REPS(12); ++rep) { phase_peer_score(F, args); SEAM(12); }
    if (IN(13)) for (int rep = 0; rep < REPS(13); ++rep) { if (PROBE_DUP == 111) { phase_peer_a(F, args, 8191, (float*)(ws + WS_X)); xcd_barrier(bar); }
        phase_peer_a(F, args, 16383, (float*)(ws + WS_B)); SEAM(13); }
    if (IN(14)) { phase_peer_coef(F, args); SEAM(14); }
    if (IN(15)) for (int rep = 0; rep < REPS(15); ++rep) { phase_peer_v(F, args, rep + 1 < REPS(15)); SEAM(15); }
    if (IN(16)) for (int rep = 0; rep < REPS(16); ++rep) {
        const int gw14 = F.bid * NWAVES + F.wave, NGW14 = F.G * NWAVES;
        for (int m = gw14; m < T; m += NGW14) rms_row_i8_b((const bf16_t*)(ws + WS_XB) + (size_t)m * D, args.in[19], ws + WS_D + (size_t)m * D, (float*)(ws + SA_R) + m, F.lane);
        { pg8::Gemm g{(const bf16_t*)(ws + WS_PBF), (const bf16_t*)(ws + WS_W_PP), 256, 256, 256}; pg8::Order<0> S; S.init(T / 256, D / 256, F.G, F.vid);
          pg8::EpiB<0> E{nullptr, nullptr, (bf16_t*)(ws + WS_A), D, nullptr, nullptr, 0, nullptr, 0, 0, 0, 1.f, nullptr};
          pg8::gemm_phase(F.lds, g, S, E); }
        SEAM(16); }
    if (IN(17)) for (int rep = 0; rep < REPS(17); ++rep) {
        pg8::Gemm g{(const bf16_t*)(ws + WS_D), (const bf16_t*)(ws + WS_W_PG), D / 2, D / 2, D / 2}; pg8::Order<0> S; S.init(T / 256, D / 256, F.G, F.vid);
        if (rep + 1 < REPS(17)) { pg8::EpiF<0, true> E{(const float*)(ws + SA_R), (const float*)(ws + SB_PG), (float*)(ws + WS_X), D, nullptr, nullptr, 0}; pg8::gemm_phase(F.lds, g, S, E); }
        else { pg8::EpiB<5, true> E{(const float*)(ws + SA_R), (const float*)(ws + SB_PG), (bf16_t*)(ws + WS_R1), D, nullptr, (const bf16_t*)(ws + WS_XB), D, (const bf16_t*)(ws + WS_A), D, 0, 0, 1.f, nullptr}; pg8::gemm_phase(F.lds, g, S, E); }
        SEAM(17); }
    if (IN(18)) for (int rep = 0; rep < REPS(18); ++rep) {
        const bf16_t* X3 = (const bf16_t*)(ws + WS_R1); const f32x4* gr = (const f32x4*)args.in[22] + F.lane;
        f32x4 gv[16];
#pragma unroll
        for (int j = 0; j < 16; ++j) gv[j] = gr[64 * j];
        for (int m = F.bid * NWAVES + F.wave; m < T; m += F.G * NWAVES) { const u32x2* xr = (const u32x2*)(X3 + (size_t)m * D) + F.lane; f32x4 v[16]; float ss = 0.f;
#pragma unroll
            for (int j = 0; j < 16; ++j) { const u32x2 q = xr[64 * j]; v[j] = (f32x4){bflo(q.x), bfhi(q.x), bflo(q.y), bfhi(q.y)}; ss += (v[j].x * v[j].x + v[j].y * v[j].y) + (v[j].z * v[j].z + v[j].w * v[j].w); }
            const float rstd = 1.f / sqrtf(wave_sum(ss) * (1.f / D) + RMS_EPS);
            f32x4* orow = (f32x4*)(args.out + (size_t)m * D) + F.lane;
#pragma unroll
            for (int j = 0; j < 16; ++j) orow[64 * j] = v[j] * rstd * gv[j]; } }
#undef IN
#undef SEAM
}

extern "C" void kernel_launch(void* const* d_in, const int* in_sizes, int n_in, void* d_out, int out_size, void* d_ws, size_t ws_size, hipStream_t stream) {
    static int grid = 0;
    if (grid == 0) {
        if (n_in != 23 || out_size != T * D || ws_size < WS_END) { fprintf(stderr, "kernel_launch: unexpected shapes n_in %d out %d ws %zu (need %zu)\n", n_in, out_size, ws_size, (size_t)WS_END); grid = -1; return; }
        int dev = 0, cus = 0, per_cu = 0;
        if (hipGetDevice(&dev) != hipSuccess || hipDeviceGetAttribute(&cus, hipDeviceAttributeMultiprocessorCount, dev) != hipSuccess) { grid = -1; return; }
        if (hipFuncSetAttribute((const void*)fwd, hipFuncAttributeMaxDynamicSharedMemorySize, LDS_BYTES) != hipSuccess) { fprintf(stderr, "kernel_launch: hipFuncSetAttribute failed\n"); grid = -1; return; }
        if (hipOccupancyMaxActiveBlocksPerMultiprocessor(&per_cu, (const void*)fwd, NTHREADS, LDS_BYTES) != hipSuccess || per_cu < 1) fprintf(stderr, "kernel_launch: occupancy query says %d\n", per_cu);
        (void)hipGetLastError();
        grid = cus;
    }
    if (grid < 0) return;
    hipMemsetAsync((char*)d_ws + WS_CTL, 0, CTL_ZERO_BYTES, stream);
    Args a{};
    for (int i = 0; i < 23; ++i) a.in[i] = (const float*)d_in[i];
    a.out = (float*)d_out; a.ws = (unsigned char*)d_ws;
#if MK_MULTI
    for (int ph = 0; ph < NPH; ++ph) { a.ph_lo = ph; a.ph_hi = ph + 1; hipLaunchKernelGGL(fwd, dim3(grid), dim3(NTHREADS), LDS_BYTES, stream, a); }
#else
    a.ph_lo = 0; a.ph_hi = NPH; hipLaunchKernelGGL(fwd, dim3(grid), dim3(NTHREADS), LDS_BYTES, stream, a);
#endif
}
```
